# Optimizing an MI355X kernel written in HIP

```python
import jax, jax.numpy as jnp
from jax import lax
import numpy as np

D_MODEL = 2048
BATCH = 2
SEQ = 4096
DEPTH = 4

HEAD_DIM = 128
CONV_CH = 512
CONV_WIDTH = 3
DSA_HEADS = 6
IDX_HEADS = 16
IDX_DIM = 64
TOPK_MAX = 256
DIL_PATTERNS = ((128, 1), (512, 4), (2048, 16))
DIL_GROUPS = 3
DIL_HEADS_PER_GROUP = 2
DIL_HEADS = DIL_GROUPS * DIL_HEADS_PER_GROUP
D_MIX = CONV_CH + DSA_HEADS * HEAD_DIM + DIL_HEADS * HEAD_DIM
SPLITS = (
    CONV_CH, CONV_CH, CONV_CH,
    DSA_HEADS * HEAD_DIM, HEAD_DIM, HEAD_DIM,
    IDX_HEADS * IDX_DIM, IDX_DIM, IDX_HEADS,
    DIL_HEADS * HEAD_DIM, DIL_HEADS * HEAD_DIM, DIL_HEADS * HEAD_DIM,
)
D_IN = sum(SPLITS)
D_FF = 5632
ROPE_THETA = 10000.0
RMS_EPS = 1e-6
Q_BLOCK = 128

kernel_name = "hybrid_conv_dsa_dilated_macaron"


def rmsnorm(x, g):
    x32 = x.astype(jnp.float32)
    y = x32 * lax.rsqrt(jnp.mean(x32 * x32, axis=-1, keepdims=True) + RMS_EPS)
    return (y * g.astype(jnp.float32)).astype(x.dtype)


def swiglu(x, w_gate, w_up, w_down):
    return (jax.nn.silu(x @ w_gate) * (x @ w_up)) @ w_down


def rope_tables(positions, dim):
    inv = 1.0 / (ROPE_THETA ** (jnp.arange(0, dim, 2, dtype=jnp.float32) / dim))
    ang = positions.astype(jnp.float32)[..., None] * inv
    return jnp.cos(ang), jnp.sin(ang)


def apply_rope(x, cos, sin):
    extra = x.ndim - 3
    shp = cos.shape[:2] + (1,) * extra + cos.shape[-1:]
    c, s = cos.reshape(shp), sin.reshape(shp)
    x1, x2 = jnp.split(x.astype(jnp.float32), 2, axis=-1)
    return jnp.concatenate([x1 * c - x2 * s, x2 * c + x1 * s], axis=-1).astype(x.dtype)


def to_blocks(a):
    b, s = a.shape[:2]
    return jnp.moveaxis(a.reshape((b, s // Q_BLOCK, Q_BLOCK) + a.shape[2:]), 1, 0)


def from_blocks(a):
    nb, b, qb, f = a.shape
    return jnp.moveaxis(a, 0, 1).reshape(b, nb * qb, f)


def short_conv_mixer(h, gate_b, gate_c, conv_w):
    u = gate_c * h
    s = u.shape[1]
    u_pad = jnp.pad(u, ((0, 0), (CONV_WIDTH - 1, 0), (0, 0)))
    y = conv_w[0] * u_pad[:, 0:s]
    for j in range(1, CONV_WIDTH):
        y = y + conv_w[j] * u_pad[:, j:j + s]
    return gate_b * y


def dsa_attention(q, k, v, q_idx, k_idx, w_idx):
    b, s = q.shape[:2]
    topk = min(TOPK_MAX, s // 4)
    scale = HEAD_DIM ** -0.5
    key_pos = jnp.arange(s)
    gather = jax.vmap(lambda kk, ii: kk[ii])

    def block(args):
        q_blk, qi_blk, w_blk, start = args
        t = start + jnp.arange(Q_BLOCK)
        causal = key_pos[None, :] <= t[:, None]
        logits = jnp.einsum('bqhd,bsd->bqhs', qi_blk, k_idx)
        score = jnp.einsum('bqh,bqhs->bqs', w_blk, jax.nn.relu(logits)).astype(jnp.float32)
        score = jnp.where(causal[None], score, -jnp.inf)
        _, sel = lax.top_k(score, topk)
        valid = sel <= t[None, :, None]
        k_sel = gather(k, sel)
        v_sel = gather(v, sel)
        att = jnp.einsum('bqhd,bqkd->bqhk', q_blk, k_sel).astype(jnp.float32) * scale
        att = jnp.where(valid[:, :, None, :], att, -jnp.inf)
        p = jax.nn.softmax(att, axis=-1)
        o = jnp.einsum('bqhk,bqkd->bqhd', p.astype(v.dtype), v_sel)
        return o.reshape(b, Q_BLOCK, DSA_HEADS * HEAD_DIM)

    starts = jnp.arange(s // Q_BLOCK) * Q_BLOCK
    out = lax.map(block, (to_blocks(q), to_blocks(q_idx), to_blocks(w_idx), starts))
    return from_blocks(out)


def dilated_attention(q, k, v):
    b, s = q.shape[:2]
    scale = HEAD_DIM ** -0.5
    k_groups = [k[:, :, g] for g in range(DIL_GROUPS)]
    v_groups = [v[:, :, g] for g in range(DIL_GROUPS)]

    def block(args):
        q_blk, start = args
        t = start + jnp.arange(Q_BLOCK)
        outs, lses = [], []
        for g, (win, dil) in enumerate(DIL_PATTERNS):
            taps = jnp.arange(win // dil + 1) * dil
            idx = t[:, None] - taps[None, :]
            valid = idx >= 0
            idx = jnp.maximum(idx, 0)
            kg = k_groups[g][:, idx]
            vg = v_groups[g][:, idx]
            sc = jnp.einsum('bqhd,bqjhd->bqhj', q_blk[:, :, g], kg).astype(jnp.float32) * scale
            sc = jnp.where(valid[None, :, None, :], sc, -jnp.inf)
            lse = jax.nn.logsumexp(sc, axis=-1)
            p = jnp.exp(sc - lse[..., None])
            outs.append(jnp.einsum('bqhj,bqjhd->bqhd', p.astype(vg.dtype), vg))
            lses.append(lse)
        o = jnp.stack(outs, axis=2)
        alpha = jax.nn.softmax(jnp.stack(lses, axis=2), axis=2)
        o = o * alpha[..., None].astype(o.dtype)
        return o.reshape(b, Q_BLOCK, DIL_HEADS * HEAD_DIM)

    starts = jnp.arange(s // Q_BLOCK) * Q_BLOCK
    out = lax.map(block, (to_blocks(q), starts))
    return from_blocks(out)


def hybrid_mixer(xn, w_in, conv_w, w_out, cos_h, sin_h, cos_i, sin_i):
    b, s, _ = xn.shape
    proj = xn @ w_in
    offsets = np.cumsum(np.array(SPLITS))[:-1].tolist()
    (h, g_b, g_c, q_b, k_b, v_b, q_i, k_i, w_i, q_c, k_c, v_c) = jnp.split(proj, offsets, axis=-1)

    y_a = short_conv_mixer(h, g_b, g_c, conv_w)

    q_b = apply_rope(q_b.reshape(b, s, DSA_HEADS, HEAD_DIM), cos_h, sin_h)
    k_b = apply_rope(k_b, cos_h, sin_h)
    q_i = apply_rope(q_i.reshape(b, s, IDX_HEADS, IDX_DIM), cos_i, sin_i) * (IDX_DIM ** -0.5)
    k_i = apply_rope(k_i, cos_i, sin_i)
    w_i = w_i * (IDX_HEADS ** -0.5)
    y_b = dsa_attention(q_b, k_b, v_b, q_i, k_i, w_i)

    gshape = (b, s, DIL_GROUPS, DIL_HEADS_PER_GROUP, HEAD_DIM)
    q_c = apply_rope(q_c.reshape(gshape), cos_h, sin_h)
    k_c = apply_rope(k_c.reshape(gshape), cos_h, sin_h)
    y_c = dilated_attention(q_c, k_c, v_c.reshape(gshape))

    return jnp.concatenate([y_a, y_b, y_c], axis=-1) @ w_out


def setup_inputs(seed: int = 0) -> dict:
    key = jax.random.key(seed)
    ks = jax.random.split(key, 16)
    nrm = lambda k, shp, fan: jax.random.normal(k, shp, jnp.float32) * (fan ** -0.5)
    gain = lambda k, shp: 1.0 + 0.02 * jax.random.normal(k, shp, jnp.float32)
    x = jax.random.normal(ks[0], (BATCH, SEQ, D_MODEL), jnp.float32)
    offs = jax.random.randint(ks[1], (BATCH, 1), 0, 1024, dtype=jnp.int32)
    positions = offs + jnp.arange(SEQ, dtype=jnp.int32)[None, :]
    return {
        "x": x,
        "positions": positions,
        "norm_ffn1": gain(ks[2], (DEPTH, D_MODEL)),
        "ffn1_gate": nrm(ks[3], (DEPTH, D_MODEL, D_FF), D_MODEL),
        "ffn1_up": nrm(ks[4], (DEPTH, D_MODEL, D_FF), D_MODEL),
        "ffn1_down": nrm(ks[5], (DEPTH, D_FF, D_MODEL), D_FF),
        "norm_mix": gain(ks[6], (DEPTH, D_MODEL)),
        "w_in": nrm(ks[7], (DEPTH, D_MODEL, D_IN), D_MODEL),
        "conv_w": nrm(ks[8], (DEPTH, CONV_WIDTH, CONV_CH), CONV_WIDTH),
        "w_out": nrm(ks[9], (DEPTH, D_MIX, D_MODEL), D_MIX),
        "norm_ffn2": gain(ks[10], (DEPTH, D_MODEL)),
        "ffn2_gate": nrm(ks[11], (DEPTH, D_MODEL, D_FF), D_MODEL),
        "ffn2_up": nrm(ks[12], (DEPTH, D_MODEL, D_FF), D_MODEL),
        "ffn2_down": nrm(ks[13], (DEPTH, D_FF, D_MODEL), D_FF),
        "norm_final": gain(ks[14], (D_MODEL,)),
    }


def reference(x, positions, norm_ffn1, ffn1_gate, ffn1_up, ffn1_down, norm_mix, w_in, conv_w, w_out,
              norm_ffn2, ffn2_gate, ffn2_up, ffn2_down, norm_final):
    cos_h, sin_h = rope_tables(positions, HEAD_DIM)
    cos_i, sin_i = rope_tables(positions, IDX_DIM)
    for i in range(DEPTH):
        x = x + 0.5 * swiglu(rmsnorm(x, norm_ffn1[i]), ffn1_gate[i], ffn1_up[i], ffn1_down[i])
        x = x + hybrid_mixer(rmsnorm(x, norm_mix[i]), w_in[i], conv_w[i], w_out[i],
                             cos_h, sin_h, cos_i, sin_i)
        x = x + 0.5 * swiglu(rmsnorm(x, norm_ffn2[i]), ffn2_gate[i], ffn2_up[i], ffn2_down[i])
    return rmsnorm(x, norm_final)
```

```cpp
#include <hip/hip_runtime.h>
#include <cstdio>
#include <cstdint>
namespace pg8 {
#define PG8_LAS __attribute__((address_space(3)))
typedef unsigned short bf16_t;
typedef short bf16x8 __attribute__((ext_vector_type(8)));
typedef float f32x4 __attribute__((ext_vector_type(4)));
typedef unsigned u32x4 __attribute__((ext_vector_type(4)));
constexpr int BM = 256, BK = 64, HALF = 128, HTB = HALF * BK * 2  , STAGE_BYTES = 8 * HTB, NXCD = 8, WGM = 8;

__host__ __device__ __forceinline__ int lds_byte(int r, int c) { const int st = (r >> 4) * 2 + (c >> 5), rr = r & 15, cc = c & 31, ob = rr * 64 + cc * 2; return st * 1024 + (ob ^ (((ob >> 9) & 1) << 5)); }
__host__ __device__ __forceinline__ void stage_rc(int b, int& R, int& C) { const int st = b / 1024, sb = b % 1024, swz = sb ^ (((sb >> 9) & 1) << 5); R = (st >> 1) * 16 + swz / 64; C = (st & 1) * 32 + (swz % 64) / 2; }
__host__ __device__ __forceinline__ int perm32(int rho) { const int n = rho >> 4, i = rho & 15; return 8 * (i >> 2) + 4 * n + (i & 3); }

struct Unit { int pm, pn; };
struct Gemm { const bf16_t* A; const bf16_t* Bt; int M, N, K; };

struct StaticOrder {
    int nM, nN, nwg, G, c;
    __host__ __device__ void init(int M, int N, int G_, int c_) { nM = M / BM; nN = N / BM; nwg = nM * nN; G = G_; c = c_; }
    __host__ __device__ bool next(int i, Unit& u) const {
        const long L = (long)i * G + c; if (L >= nwg) return false;
        int wgid = (int)L; { const int q = nwg / NXCD, r = nwg % NXCD, xcd = wgid % NXCD, off = wgid / NXCD; wgid = (xcd < r ? xcd * (q + 1) : r * (q + 1) + (xcd - r) * q) + off; }
        const int nig = WGM * nN, gid = wgid / nig, fm = gid * WGM, gsz = (nM - fm) < WGM ? (nM - fm) : WGM;
        u.pm = fm + ((wgid % nig) % gsz); u.pn = (wgid % nig) / gsz; return true;
    }
    __device__ __forceinline__ void a_ready(const Unit&) const {}
    __device__ __forceinline__ void done(const Unit&) const {}
};

__device__ __forceinline__ unsigned cvt_pk_bf16(float lo, float hi) { unsigned r; asm volatile("v_cvt_pk_bf16_f32 %0, %1, %2" : "=v"(r) : "v"(lo), "v"(hi)); return r; }
typedef float f32x2 __attribute__((ext_vector_type(2)));
struct EpiStoreBf16 {
    static constexpr bool PERM = true, AFTER_DRAIN = false;
    bf16_t* O; int ldc;
    __device__ __forceinline__ void operator()(const f32x4 (&acc)[2][2][4][2], const Unit& u, int wr, int wc, int fr, int fq) const {
        const int row0 = u.pm * BM + wr * 64 + fr, col0 = u.pn * BM + wc * 32 + 8 * fq;
#pragma unroll
        for (int ai = 0; ai < 2; ++ai)
#pragma unroll
            for (int m = 0; m < 4; ++m) { bf16_t* rowp = O + (size_t)(row0 + ai * HALF + m * 16) * ldc + col0;
#pragma unroll
                for (int bj = 0; bj < 2; ++bj) { const f32x4 v0 = acc[ai][bj][m][0], v1 = acc[ai][bj][m][1];
                    u32x4 w; w.x = cvt_pk_bf16(v0[0], v0[1]); w.y = cvt_pk_bf16(v0[2], v0[3]); w.z = cvt_pk_bf16(v1[0], v1[1]); w.w = cvt_pk_bf16(v1[2], v1[3]);
                    *(u32x4*)(rowp + bj * HALF) = w; } }
    }
};
struct EpiSwiglu {
    static constexpr bool PERM = true, AFTER_DRAIN = false;
    bf16_t* H; int ldh;
    __device__ __forceinline__ static float silu_mul(float g, float u) { return g * u * __builtin_amdgcn_rcpf(1.0f + __builtin_amdgcn_exp2f(-1.4426950408889634f * g)); }
    __device__ __forceinline__ void operator()(const f32x4 (&acc)[2][2][4][2], const Unit& u, int wr, int wc, int fr, int fq) const {
        const int row0 = u.pm * BM + wr * 64 + fr, col0 = u.pn * HALF + wc * 32 + 8 * fq;
#pragma unroll
        for (int ai = 0; ai < 2; ++ai)
#pragma unroll
            for (int m = 0; m < 4; ++m) { bf16_t* rowp = H + (size_t)(row0 + ai * HALF + m * 16) * ldh + col0;
                const f32x4 g0 = acc[ai][0][m][0], g1 = acc[ai][0][m][1], u0 = acc[ai][1][m][0], u1 = acc[ai][1][m][1];
                u32x4 w;
                w.x = cvt_pk_bf16(silu_mul(g0[0], u0[0]), silu_mul(g0[1], u0[1])); w.y = cvt_pk_bf16(silu_mul(g0[2], u0[2]), silu_mul(g0[3], u0[3]));
                w.z = cvt_pk_bf16(silu_mul(g1[0], u1[0]), silu_mul(g1[1], u1[1])); w.w = cvt_pk_bf16(silu_mul(g1[2], u1[2]), silu_mul(g1[3], u1[3]));
                *(u32x4*)rowp = w; }
    }
};
struct EpiResid {
    static constexpr bool PERM = false, AFTER_DRAIN = false;
    const float* src; float* dst; int ldc; float scale;
    __device__ __forceinline__ void operator()(const f32x4 (&acc)[2][2][4][2], const Unit& u, int wr, int wc, int fr, int fq) const {
        const int row0 = u.pm * BM + wr * 64 + fr, col0 = u.pn * BM + wc * 32 + 4 * fq;
#pragma unroll
        for (int ai = 0; ai < 2; ++ai)
#pragma unroll
            for (int m = 0; m < 4; ++m) { const size_t off = (size_t)(row0 + ai * HALF + m * 16) * ldc + col0;
#pragma unroll
                for (int bj = 0; bj < 2; ++bj)
#pragma unroll
                    for (int n = 0; n < 2; ++n) { const f32x4 b = *(const f32x4*)(src + off + bj * HALF + n * 16); *(f32x4*)(dst + off + bj * HALF + n * 16) = b + acc[ai][bj][m][n] * scale; }
                asm volatile("" ::: "memory"); }
    }
};
template <class Epi, class Sched, bool ALIGN_EPI = false, bool SP2 = false>
__device__ __forceinline__ void gemm_phase(PG8_LAS unsigned char* lds, const Gemm g, const Sched& S, const Epi& E, const int tid_in  ) {
    const int tid = tid_in, wid = __builtin_amdgcn_readfirstlane(tid >> 6), lane = tid & 63, wr = wid >> 2, wc = wid & 3, fr = lane & 15, fq = lane >> 4;
    const int K = g.K, nt = K / BK;
    unsigned voffA[2], voffB[2];
#pragma unroll
    for (int i = 0; i < 2; ++i) { int R, C; stage_rc(tid * 16 + i * 8192, R, C); const int Rb = Epi::PERM ? ((R & ~31) + perm32(R & 31)) : R;
        voffA[i] = (unsigned)(R * K + C) * 2u; voffB[i] = (unsigned)(Rb * K + C) * 2u; }
    const size_t kstep = (size_t)(BK * 2);
    const size_t hstep = (size_t)HALF * K * 2;
    const size_t tstep = 2 * hstep;
    const unsigned ldsw = (unsigned)wid * 1024u;
    const int aoff = lds_byte(wr * 64 + fr, fq * 8), boff = lds_byte(wc * 32 + fr, fq * 8);
#define PG8_SA(b, h) (((b) * 2 + (h)) * HTB)
#define PG8_SB(b, h) ((4 + (b) * 2 + (h)) * HTB)
#define PG8_STAGE(bufoff, gbase, voff) do { _Pragma("unroll") for (int _i = 0; _i < 2; ++_i) \
        __builtin_amdgcn_global_load_lds((const unsigned*)((const char*)(gbase) + (voff)[_i]), (PG8_LAS unsigned*)(lds + (bufoff) + ldsw + _i * 8192), 16, 0, 0); } while (0)
#define PG8_LDA(dst, b, h) do { _Pragma("unroll") for (int m = 0; m < 4; ++m) _Pragma("unroll") for (int k = 0; k < 2; ++k) dst[m][k] = *(const PG8_LAS bf16x8*)(lds + PG8_SA(b, h) + aoff + m * 2048 + k * 1024); } while (0)
#define PG8_LDB(dst, b, h) do { _Pragma("unroll") for (int n = 0; n < 2; ++n) _Pragma("unroll") for (int k = 0; k < 2; ++k) dst[n][k] = *(const PG8_LAS bf16x8*)(lds + PG8_SB(b, h) + boff + n * 2048 + k * 1024); } while (0)
#define PG8_MMA(ai, bj, At, Bt) do { __builtin_amdgcn_s_setprio(1); _Pragma("unroll") for (int m = 0; m < 4; ++m) _Pragma("unroll") for (int n = 0; n < 2; ++n) _Pragma("unroll") for (int k = 0; k < 2; ++k) \
        acc[ai][bj][m][n] = __builtin_amdgcn_mfma_f32_16x16x32_bf16(Bt[n][k], At[m][k], acc[ai][bj][m][n], 0, 0, 0); __builtin_amdgcn_s_setprio(0); } while (0)
#define PG8_WAIT_V(n) asm volatile("s_waitcnt vmcnt(" #n ")" ::: "memory")
#define PG8_WAIT_L(n) asm volatile("s_waitcnt lgkmcnt(" #n ")" ::: "memory")
#define PG8_BAR __builtin_amdgcn_s_barrier()
#define PG8_SCHED __builtin_amdgcn_sched_barrier(0)
    Unit cur, nxt; int ui = 0;
    if (!S.next(0, cur)) return;
    f32x4 acc[2][2][4][2];
#pragma unroll
    for (int a = 0; a < 2; ++a)
#pragma unroll
        for (int b = 0; b < 2; ++b)
#pragma unroll
            for (int m = 0; m < 4; ++m)
#pragma unroll
                for (int n = 0; n < 2; ++n) acc[a][b][m][n] = (f32x4){0.f, 0.f, 0.f, 0.f};
    bf16x8 At[4][2], B0[2][2], B1[2][2];
    const char* cA = (const char*)g.A + (size_t)cur.pm * tstep; const char* cB = (const char*)g.Bt + (size_t)cur.pn * tstep;
    S.a_ready(cur);
    if constexpr (SP2) {
        PG8_STAGE(PG8_SB(0, 0), cB, voffB); PG8_STAGE(PG8_SB(0, 1), cB + hstep, voffB); PG8_STAGE(PG8_SA(0, 0), cA, voffA); PG8_STAGE(PG8_SA(0, 1), cA + hstep, voffA);
        if (wr == 1) PG8_BAR;
        PG8_WAIT_V(2); PG8_BAR;
        PG8_STAGE(PG8_SB(1, 0), cB + kstep, voffB); PG8_STAGE(PG8_SA(1, 0), cA + kstep, voffA); PG8_STAGE(PG8_SB(1, 1), cB + hstep + kstep, voffB);
        PG8_WAIT_V(6); PG8_BAR;
    } else {
        PG8_STAGE(PG8_SB(0, 0), cB, voffB); PG8_STAGE(PG8_SA(0, 0), cA, voffA); PG8_STAGE(PG8_SB(0, 1), cB + hstep, voffB); PG8_STAGE(PG8_SA(0, 1), cA + hstep, voffA);
        if (wr == 1) PG8_BAR;
        PG8_WAIT_V(4); PG8_BAR;
        PG8_STAGE(PG8_SB(1, 0), cB + kstep, voffB); PG8_STAGE(PG8_SA(1, 0), cA + kstep, voffA); PG8_STAGE(PG8_SB(1, 1), cB + hstep + kstep, voffB);
        PG8_WAIT_V(6); PG8_BAR;
    }
    for (;;) {
        const bool has_next = S.next(ui + 1, nxt);
        const char* nA = has_next ? (const char*)g.A + (size_t)nxt.pm * tstep : cA; const char* nB = has_next ? (const char*)g.Bt + (size_t)nxt.pn * tstep : cB;
        for (int t = 0; t < nt; t += 2) {
            const bool last = (t == nt - 2);
            const char* a1 = cA + (size_t)(t + 1) * kstep;
            const char* a2 = last ? nA : cA + (size_t)(t + 2) * kstep; const char* b2 = last ? nB : cB + (size_t)(t + 2) * kstep;
            const char* a3 = a2 + kstep; const char* b3 = b2 + kstep;
            if (last && has_next) S.a_ready(nxt);
            if constexpr (SP2) {
            PG8_LDB(B0, 0, 0); PG8_LDB(B1, 0, 1); PG8_SCHED; PG8_LDA(At, 0, 0); PG8_STAGE(PG8_SA(1, 1), a1 + hstep, voffA);
            PG8_WAIT_V(8); PG8_WAIT_L(0); PG8_BAR; PG8_MMA(0, 0, At, B0); PG8_MMA(0, 1, At, B1); PG8_BAR; PG8_SCHED;
            PG8_LDA(At, 0, 1); PG8_STAGE(PG8_SB(0, 0), b2, voffB); PG8_STAGE(PG8_SB(0, 1), b2 + hstep, voffB); PG8_STAGE(PG8_SA(0, 0), a2, voffA);
            PG8_WAIT_V(8); PG8_WAIT_L(0); PG8_BAR; PG8_MMA(1, 0, At, B0); PG8_MMA(1, 1, At, B1); PG8_BAR; PG8_SCHED;
            PG8_LDB(B0, 1, 0); PG8_LDB(B1, 1, 1); PG8_SCHED; PG8_LDA(At, 1, 0); PG8_STAGE(PG8_SA(0, 1), a2 + hstep, voffA);
            PG8_WAIT_V(8); PG8_WAIT_L(0); PG8_BAR; PG8_MMA(0, 0, At, B0); PG8_MMA(0, 1, At, B1); PG8_BAR; PG8_SCHED;
            PG8_LDA(At, 1, 1); PG8_STAGE(PG8_SB(1, 0), b3, voffB); PG8_STAGE(PG8_SB(1, 1), b3 + hstep, voffB); PG8_STAGE(PG8_SA(1, 0), a3, voffA);
            PG8_WAIT_V(8); PG8_WAIT_L(0); PG8_BAR; PG8_MMA(1, 0, At, B0); PG8_MMA(1, 1, At, B1); PG8_BAR; PG8_SCHED;
            } else {
            PG8_LDB(B0, 0, 0); PG8_SCHED; PG8_LDA(At, 0, 0); PG8_STAGE(PG8_SA(1, 1), a1 + hstep, voffA);
            PG8_WAIT_L(8); PG8_BAR; PG8_WAIT_L(0); PG8_MMA(0, 0, At, B0); PG8_BAR; PG8_SCHED;
            PG8_LDB(B1, 0, 1); PG8_STAGE(PG8_SB(0, 0), b2, voffB);
            PG8_BAR; PG8_WAIT_L(0); PG8_MMA(0, 1, At, B1); PG8_BAR;
            PG8_LDA(At, 0, 1); PG8_STAGE(PG8_SA(0, 0), a2, voffA);
            PG8_BAR; PG8_WAIT_L(0); PG8_MMA(1, 0, At, B0); PG8_BAR; PG8_SCHED;
            PG8_STAGE(PG8_SB(0, 1), b2 + hstep, voffB);
            PG8_WAIT_V(6); PG8_BAR; PG8_MMA(1, 1, At, B1); PG8_BAR;
            PG8_LDB(B0, 1, 0); PG8_SCHED; PG8_LDA(At, 1, 0); PG8_STAGE(PG8_SA(0, 1), a2 + hstep, voffA);
            PG8_WAIT_L(8); PG8_BAR; PG8_WAIT_L(0); PG8_MMA(0, 0, At, B0); PG8_BAR; PG8_SCHED;
            PG8_LDB(B1, 1, 1); PG8_STAGE(PG8_SB(1, 0), b3, voffB);
            PG8_BAR; PG8_WAIT_L(0); PG8_MMA(0, 1, At, B1); PG8_BAR;
            PG8_LDA(At, 1, 1); PG8_STAGE(PG8_SA(1, 0), a3, voffA);
            PG8_BAR; PG8_WAIT_L(0); PG8_MMA(1, 0, At, B0); PG8_BAR; PG8_SCHED;
            PG8_STAGE(PG8_SB(1, 1), b3 + hstep, voffB);
            PG8_WAIT_V(6); PG8_BAR; PG8_MMA(1, 1, At, B1); PG8_BAR;
            }
        }
        if constexpr (ALIGN_EPI) { if (wr == 0) PG8_BAR; }
        if constexpr (!Epi::AFTER_DRAIN) { E(acc, cur, wr, wc, fr, fq); S.done(cur); }
        if (!has_next) break;
#pragma unroll
        for (int a = 0; a < 2; ++a)
#pragma unroll
            for (int b = 0; b < 2; ++b)
#pragma unroll
                for (int m = 0; m < 4; ++m)
#pragma unroll
                    for (int n = 0; n < 2; ++n) acc[a][b][m][n] = (f32x4){0.f, 0.f, 0.f, 0.f};
        cur = nxt; cA = nA; cB = nB; ++ui;
        if constexpr (ALIGN_EPI) { if (wr == 1) PG8_BAR; }
    }
    PG8_WAIT_V(0);
    if constexpr (!ALIGN_EPI) { if (wr == 0) PG8_BAR; }
    PG8_BAR;
    if constexpr (Epi::AFTER_DRAIN) { E.fused(acc, cur, wr, wc, fr, fq, lds, wid, lane); S.done(cur); }
#undef PG8_SA
#undef PG8_SB
#undef PG8_STAGE
#undef PG8_LDA
#undef PG8_LDB
#undef PG8_MMA
#undef PG8_WAIT_V
#undef PG8_WAIT_L
#undef PG8_BAR
#undef PG8_SCHED
}
}
#define LAS __attribute__((address_space(3)))
#define XB_TMO      128
#define XB_XCNT(j)  (256  + 64 * (j))
#define XB_XSUB(j)  (1280 + 64 * (j))
#define XB_XGEN(j)  (2304 + 64 * (j))
#define XB_TOP      3328
#define XB_TOPGEN   3392
#define XCD_BAR_WORDS 3456
#define XB_SPIN_CAP (1u << 18)

__device__ __forceinline__ unsigned xb_ld(unsigned* p)              { return __hip_atomic_load(p, __ATOMIC_RELAXED, __HIP_MEMORY_SCOPE_AGENT); }
__device__ __forceinline__ unsigned xb_add(unsigned* p, unsigned v) { return __hip_atomic_fetch_add(p, v, __ATOMIC_RELAXED, __HIP_MEMORY_SCOPE_AGENT); }
__device__ __forceinline__ unsigned xb_xcc_id() { return (unsigned)__builtin_amdgcn_s_getreg((3 << 11) | 20) & 0xFu; }
#define XB_SPIN(cond, bar) do { unsigned _sp = 0; while (cond) { __builtin_amdgcn_s_sleep(1); \
    if ((++_sp & 255u) == 0u) { if (xb_ld(&(bar)[XB_TMO])) break; if (_sp > XB_SPIN_CAP) { atomicAdd(&(bar)[XB_TMO], 1u); break; } } } } while (0)

struct XcdBarrier {
    unsigned* bar; unsigned x;
    volatile LAS unsigned* st;
};

__device__ __forceinline__ XcdBarrier xcd_barrier_post(unsigned* bar, volatile LAS unsigned* st) {
    XcdBarrier b; b.bar = bar; b.x = xb_xcc_id(); b.st = st;
    if (threadIdx.x == 0) (void)xb_add(&bar[XB_XCNT(b.x)], 1u);
    return b;
}
__device__ __forceinline__ void xcd_barrier_complete(unsigned* bar, unsigned x, unsigned& nloc, unsigned& nx) {
    const unsigned G = gridDim.x * gridDim.y * gridDim.z;
    unsigned sum, cnt, mine, sp = 0u;
    for (;;) {
        sum = 0u; cnt = 0u; mine = 0u;
#pragma unroll
        for (unsigned j = 0; j < 16; ++j) { const unsigned c = xb_ld(&bar[XB_XCNT(j)]); sum += c; cnt += (c > 0u) ? 1u : 0u; mine = (j == x) ? c : mine; }
        if (sum == G) break;
        __builtin_amdgcn_s_sleep(1);
        if ((++sp & 255u) == 0u) { if (xb_ld(&bar[XB_TMO])) break; if (sp > XB_SPIN_CAP) { atomicAdd(&bar[XB_TMO], 1u); break; } }
    }
    nloc = mine > 0u ? mine : 1u; nx = cnt > 0u ? cnt : 1u;
}

__device__ __forceinline__ void xcd_barrier(const XcdBarrier& b) {
    asm volatile("s_waitcnt vmcnt(0)" ::: "memory");
    __syncthreads();
    if (threadIdx.x == 0) {
        unsigned* bar = b.bar;
        __builtin_amdgcn_s_waitcnt(0);
        unsigned nloc = b.st[0], nx = b.st[1];
        if (nloc == 0u) { xcd_barrier_complete(bar, b.x, nloc, nx); b.st[0] = nloc; b.st[1] = nx; }
        const unsigned old = xb_add(&bar[XB_XSUB(b.x)], 1u);
        const unsigned gen = old / nloc;
        if (old + 1u == (gen + 1u) * nloc) {
            __builtin_amdgcn_fence(__ATOMIC_RELEASE, "agent");
            asm volatile("s_waitcnt vmcnt(0)" ::: "memory");
            const unsigned og = xb_add(&bar[XB_TOP], 1u);
            const unsigned tg = og / nx;
            if (og + 1u == (tg + 1u) * nx) xb_add(&bar[XB_TOPGEN], 1u);
            else XB_SPIN(xb_ld(&bar[XB_TOPGEN]) == tg, bar);
            __builtin_amdgcn_fence(__ATOMIC_ACQUIRE, "agent");
            xb_add(&bar[XB_XGEN(b.x)], 1u);
            asm volatile("s_waitcnt vmcnt(0)" ::: "memory");
        } else {
            XB_SPIN(xb_ld(&bar[XB_XGEN(b.x)]) == gen, bar);
            __builtin_amdgcn_fence(__ATOMIC_ACQUIRE, "agent");
            asm volatile("s_waitcnt vmcnt(0)" ::: "memory");
        }
    }
    __syncthreads();
}
constexpr int BATCH = 2, SEQ = 4096, M = BATCH * SEQ, D = 2048, FF = 5632, DEPTH = 4, DIN = 5968, LDP = 6144;
constexpr int NWAVES = 8;
constexpr int P_H = 0, P_GB = 512, P_GC = 1024, P_QB = 1536, P_KB = 2304, P_VB = 2432, P_QI = 2560, P_KI = 3584, P_QC = 3648, P_KC = 4416, P_VC = 5184, P_WI = 5952;
constexpr int Y_A = 0, Y_B = 512, Y_C = 1280;
constexpr float RMS_EPS = 1e-6f;
constexpr float SM_C = 0.08838834764831845f * 1.4426950408889634f;

constexpr size_t MiB = 1u << 20;
constexpr size_t WS_CTL = 0, CTL_ZERO_BYTES = 1 * MiB;
constexpr size_t WS_COSH = 1 * MiB, WS_SINH = 3 * MiB, WS_COSI = 5 * MiB, WS_SINI = 6 * MiB, WS_LSE = 7 * MiB;
constexpr size_t WS_XN = 8 * MiB, WS_YMIX = 40 * MiB, WS_H = 72 * MiB, WS_PROJ = 160 * MiB, WS_SCORES = 256 * MiB, WS_W = 384 * MiB;
constexpr size_t WL_GU1 = 0, WL_D1 = 44 * MiB, WL_IN = 66 * MiB, WL_OUT = 90 * MiB, WL_GU2 = 98 * MiB, WL_D2 = 142 * MiB, WL_STRIDE = 164 * MiB;
constexpr size_t WS_END = WS_W + DEPTH * WL_STRIDE;
static_assert((size_t)M * FF * 2 <= WS_PROJ - WS_H && (size_t)M * LDP * 2 <= WS_SCORES - WS_PROJ && (size_t)M * SEQ * 4 <= WS_W - WS_SCORES, "ws map");
static_assert((size_t)2 * FF * D * 2 <= WL_D1 && (size_t)D * FF * 2 <= WL_IN - WL_D1 && (size_t)LDP * D * 2 <= WL_OUT - WL_IN && (size_t)D * D * 2 <= WL_GU2 - WL_OUT, "weight map");
constexpr int CW_BAR = 4096;

constexpr int RING_BYTES = 131072, MISC_OFF = RING_BYTES + 320, LDS_BYTES = 147456;

typedef unsigned short bf16;
typedef unsigned v4u __attribute__((ext_vector_type(4)));
typedef unsigned v2u __attribute__((ext_vector_type(2)));
typedef float f32x4 __attribute__((ext_vector_type(4)));
typedef float f32x16 __attribute__((ext_vector_type(16)));
typedef short bf16x8 __attribute__((ext_vector_type(8)));
typedef short s16x4 __attribute__((ext_vector_type(4)));

__device__ __forceinline__ unsigned f2bf(float f) { unsigned u = __builtin_bit_cast(unsigned, f); return (u + 0x7fffu + ((u >> 16) & 1u)) >> 16; }
__device__ __forceinline__ unsigned pk2(float lo, float hi) { return f2bf(lo) | (f2bf(hi) << 16); }
__device__ __forceinline__ float bf_lo(unsigned w) { return __builtin_bit_cast(float, w << 16); }
__device__ __forceinline__ float bf_hi(unsigned w) { return __builtin_bit_cast(float, w & 0xffff0000u); }
__device__ __forceinline__ float bf2f(bf16 b) { return __builtin_bit_cast(float, (unsigned)b << 16); }
__device__ __forceinline__ float wave_sum(float v) {
#pragma unroll
    for (int o = 1; o < 64; o <<= 1) v += __shfl_xor(v, o);
    return v;
}

__device__ const float INV_H[64] = {
1.000000000e+00f, 8.659643531e-01f, 7.498942018e-01f, 6.493816376e-01f, 5.623413324e-01f, 4.869675338e-01f, 4.216965139e-01f, 3.651741147e-01f, 3.162277639e-01f, 2.738419771e-01f, 2.371373922e-01f, 2.053525001e-01f, 1.778279394e-01f, 1.539926529e-01f, 1.333521456e-01f, 1.154782027e-01f, 1.000000015e-01f, 8.659642935e-02f, 7.498941571e-02f, 6.493816525e-02f, 5.623412877e-02f, 4.869675264e-02f, 4.216964915e-02f, 3.651741147e-02f, 3.162277862e-02f, 2.738419734e-02f, 2.371373586e-02f, 2.053524926e-02f, 1.778279431e-02f, 1.539926510e-02f, 1.333521493e-02f, 1.154781971e-02f, 9.999999776e-03f, 8.659643121e-03f, 7.498942316e-03f, 6.493816618e-03f, 5.623413250e-03f, 4.869675264e-03f, 4.216964822e-03f, 3.651741426e-03f, 3.162277862e-03f, 2.738419687e-03f, 2.371373819e-03f, 2.053525066e-03f, 1.778279431e-03f, 1.539926627e-03f, 1.333521446e-03f, 1.154781901e-03f, 1.000000047e-03f, 8.659643354e-04f, 7.498941850e-04f, 6.493816618e-04f, 5.623413017e-04f, 4.869675031e-04f, 4.216965463e-04f, 3.651741135e-04f, 3.162277862e-04f, 2.738419571e-04f, 2.371373848e-04f, 2.053525241e-04f, 1.778279402e-04f, 1.539926452e-04f, 1.333521504e-04f, 1.154782076e-04f };

struct Frame {
    LAS unsigned char* lds;
    int tid, lane, wave, bid, G, gw, NGW;
    unsigned char* ws;
};

template <int MODE> __device__ __forceinline__ int rowmap(int n) {
    if (MODE == 1) return 256 * (n >> 7) + (n & 127);
    if (MODE == 2) return 256 * (n >> 7) + 128 + (n & 127);
    if (MODE == 3) return n < 3648 ? n : (n < 3664 ? P_WI + (n - 3648) : n - 16);
    return n;
}
template <int MODE> __device__ __forceinline__ void transpose_item(const float* W, int K, int N, bf16* WT, LAS float* scr, int item, int lane) {
    const int nblk = (N + 31) / 32, kb = item / nblk, nb = item % nblk, k0 = 64 * kb, n0 = 32 * nb;
    const int nn = n0 + (lane & 31); const bool nok = nn < N;
#pragma unroll 8
    for (int i = 0; i < 32; ++i) { const int kk = 2 * i + (lane >> 5); scr[kk * 33 + (lane & 31)] = nok ? W[(size_t)(k0 + kk) * N + nn] : 0.f; }
    asm volatile("s_waitcnt lgkmcnt(0)" ::: "memory");
    const int c = lane & 7;
#pragma unroll
    for (int j = 0; j < 4; ++j) { const int n = (lane >> 3) + 8 * j; const LAS float* s = scr + (8 * c) * 33 + n;
        v4u o; o.x = pk2(s[0 * 33], s[1 * 33]); o.y = pk2(s[2 * 33], s[3 * 33]); o.z = pk2(s[4 * 33], s[5 * 33]); o.w = pk2(s[6 * 33], s[7 * 33]);
        if (n0 + n < N) *(v4u*)(WT + (size_t)rowmap<MODE>(n0 + n) * K + k0 + 8 * c) = o; }
    asm volatile("s_waitcnt lgkmcnt(0)" ::: "memory");
}
__device__ __forceinline__ void sincos_d(double a, float& sn, float& cs) {
    const double k = __builtin_rint(a * 0.63661977236758134308);
    double r = __builtin_fma(-k, 1.57079632679489655800e+00, a); r = __builtin_fma(-k, 6.12323399573676603587e-17, r);
    const int q = (int)((long long)k & 3);
    const double r2 = r * r;
    double s = -1.0 / 39916800.0; s = s * r2 + 1.0 / 362880.0; s = s * r2 - 1.0 / 5040.0; s = s * r2 + 1.0 / 120.0; s = s * r2 - 1.0 / 6.0; s = s * r2 * r + r;
    double c = 1.0 / 479001600.0; c = c * r2 - 1.0 / 3628800.0; c = c * r2 + 1.0 / 40320.0; c = c * r2 - 1.0 / 720.0; c = c * r2 + 1.0 / 24.0; c = c * r2 - 0.5; c = c * r2 + 1.0;
    const double ss = (q & 1) ? c : s, cc = (q & 1) ? s : c;
    sn = (float)((q & 2) ? -ss : ss); cs = (float)(((q + 1) & 2) ? -cc : cc);
}
struct Args { const void* in[15]; float* out; unsigned char* ws; int ph_lo, ph_hi; };
#define IN_X ((const float*)args.in[0])
#define IN_POS ((const int*)args.in[1])
#define IN_N1 ((const float*)args.in[2])
#define IN_G1 ((const float*)args.in[3])
#define IN_U1 ((const float*)args.in[4])
#define IN_D1 ((const float*)args.in[5])
#define IN_NM ((const float*)args.in[6])
#define IN_WIN ((const float*)args.in[7])
#define IN_CW ((const float*)args.in[8])
#define IN_WOUT ((const float*)args.in[9])
#define IN_N2 ((const float*)args.in[10])
#define IN_G2 ((const float*)args.in[11])
#define IN_U2 ((const float*)args.in[12])
#define IN_D2 ((const float*)args.in[13])
#define IN_NF ((const float*)args.in[14])
__device__ __forceinline__ void prologue(Frame& F, const Args& args) {
    LAS float* scr = (LAS float*)(F.lds + F.wave * 16384);
    constexpr int I_G = (D / 64) * (FF / 32), I_D = (FF / 64) * (D / 32), I_IN = (D / 64) * ((DIN + 31) / 32), I_OUT = (D / 64) * (D / 32);
    constexpr int PER_LAYER = 4 * I_G + 2 * I_D + I_IN + I_OUT;
    for (int it = F.gw; it < DEPTH * PER_LAYER; it += F.NGW) {
        const int L = it / PER_LAYER; int r = it % PER_LAYER;
        unsigned char* wl = F.ws + WS_W + (size_t)L * WL_STRIDE;
        const size_t og = (size_t)L * D * FF, oin = (size_t)L * D * DIN, oout = (size_t)L * D * D;
        if (r < I_G) { transpose_item<1>(IN_G1 + og, D, FF, (bf16*)(wl + WL_GU1), scr, r, F.lane); continue; } r -= I_G;
        if (r < I_G) { transpose_item<2>(IN_U1 + og, D, FF, (bf16*)(wl + WL_GU1), scr, r, F.lane); continue; } r -= I_G;
        if (r < I_D) { transpose_item<0>(IN_D1 + og, FF, D, (bf16*)(wl + WL_D1), scr, r, F.lane); continue; } r -= I_D;
        if (r < I_G) { transpose_item<1>(IN_G2 + og, D, FF, (bf16*)(wl + WL_GU2), scr, r, F.lane); continue; } r -= I_G;
        if (r < I_G) { transpose_item<2>(IN_U2 + og, D, FF, (bf16*)(wl + WL_GU2), scr, r, F.lane); continue; } r -= I_G;
        if (r < I_D) { transpose_item<0>(IN_D2 + og, FF, D, (bf16*)(wl + WL_D2), scr, r, F.lane); continue; } r -= I_D;
        if (r < I_IN) { transpose_item<3>(IN_WIN + oin, D, DIN, (bf16*)(wl + WL_IN), scr, r, F.lane); continue; } r -= I_IN;
        transpose_item<0>(IN_WOUT + oout, D, D, (bf16*)(wl + WL_OUT), scr, r, F.lane);
    }
    for (int L = 0; L < DEPTH; ++L) { v4u* p = (v4u*)(F.ws + WS_W + (size_t)L * WL_STRIDE + WL_IN + (size_t)DIN * D * 2);
        for (int i = F.gw * 64 + F.lane; i < (LDP - DIN) * D * 2 / 16; i += F.NGW * 64) p[i] = (v4u){0u, 0u, 0u, 0u}; }
    float* cosh_ = (float*)(F.ws + WS_COSH); float* sinh_ = (float*)(F.ws + WS_SINH); float* cosi_ = (float*)(F.ws + WS_COSI); float* sini_ = (float*)(F.ws + WS_SINI);
    for (int m = F.gw; m < M; m += F.NGW) { const float p = (float)IN_POS[m];
        { const float a = p * INV_H[F.lane]; float s, c; sincos_d((double)a, s, c); cosh_[m * 64 + F.lane] = c; sinh_[m * 64 + F.lane] = s; }
        if (F.lane < 32) { const float a = p * INV_H[2 * F.lane]; float s, c; sincos_d((double)a, s, c); cosi_[m * 32 + F.lane] = c; sini_[m * 32 + F.lane] = s; } }
}

__device__ __forceinline__ void norm_phase(Frame& F, const float* x, const float* g, bf16* xn) {
    for (int m = F.gw; m < M; m += F.NGW) {
        const f32x4* xr = (const f32x4*)(x + (size_t)m * D) + F.lane; f32x4 v[8]; float s = 0.f;
#pragma unroll
        for (int j = 0; j < 8; ++j) { v[j] = xr[64 * j]; s += (v[j].x * v[j].x + v[j].y * v[j].y) + (v[j].z * v[j].z + v[j].w * v[j].w); }
        const float r = 1.0f / sqrtf(wave_sum(s) * (1.0f / D) + RMS_EPS);
        v2u* o = (v2u*)(xn + (size_t)m * D) + F.lane;
#pragma unroll
        for (int j = 0; j < 8; ++j) { const f32x4 gg = ((const f32x4*)g)[F.lane + 64 * j]; v2u w; w.x = pk2(v[j].x * r * gg.x, v[j].y * r * gg.y); w.y = pk2(v[j].z * r * gg.z, v[j].w * r * gg.w); o[64 * j] = w; }
    }
}
__device__ __forceinline__ void final_norm_phase(Frame& F, float* x, const float* g) {
    for (int m = F.gw; m < M; m += F.NGW) {
        f32x4* xr = (f32x4*)(x + (size_t)m * D) + F.lane; f32x4 v[8]; float s = 0.f;
#pragma unroll
        for (int j = 0; j < 8; ++j) { v[j] = xr[64 * j]; s += (v[j].x * v[j].x + v[j].y * v[j].y) + (v[j].z * v[j].z + v[j].w * v[j].w); }
        const float r = 1.0f / sqrtf(wave_sum(s) * (1.0f / D) + RMS_EPS);
#pragma unroll
        for (int j = 0; j < 8; ++j) { const f32x4 gg = ((const f32x4*)g)[F.lane + 64 * j]; xr[64 * j] = v[j] * r * gg; }
    }
}

__device__ __forceinline__ void rope_conv_phase(Frame& F, bf16* proj, bf16* ymix, const float* convw  ) {
    const float* cosh_ = (const float*)(F.ws + WS_COSH); const float* sinh_ = (const float*)(F.ws + WS_SINH); const float* cosi_ = (const float*)(F.ws + WS_COSI); const float* sini_ = (const float*)(F.ws + WS_SINI);
    const int lane = F.lane;
    for (int m = F.gw; m < M; m += F.NGW) {
        bf16* row = proj + (size_t)m * LDP;
        { const float c = cosh_[m * 64 + lane], s = sinh_[m * 64 + lane];
#pragma unroll
          for (int hd = 0; hd < 19; ++hd) { const int base = hd < 6 ? P_QB + hd * 128 : (hd == 6 ? P_KB : (hd < 13 ? P_QC + (hd - 7) * 128 : P_KC + (hd - 13) * 128));
              const float x1 = bf2f(row[base + lane]), x2 = bf2f(row[base + 64 + lane]);
              row[base + lane] = (bf16)f2bf(x1 * c - x2 * s); row[base + 64 + lane] = (bf16)f2bf(x2 * c + x1 * s); } }
        { const int d = lane & 31, hp = lane >> 5; const float c = cosi_[m * 32 + d], s = sini_[m * 32 + d];
#pragma unroll
          for (int i = 0; i < 8; ++i) { const int base = P_QI + (2 * i + hp) * 64;
              const float x1 = bf2f(row[base + d]), x2 = bf2f(row[base + 32 + d]);
              row[base + d] = (bf16)f2bf((x1 * c - x2 * s) * 0.125f); row[base + 32 + d] = (bf16)f2bf((x2 * c + x1 * s) * 0.125f); }
          if (hp == 0) { const float x1 = bf2f(row[P_KI + d]), x2 = bf2f(row[P_KI + 32 + d]);
              row[P_KI + d] = (bf16)f2bf(x1 * c - x2 * s); row[P_KI + 32 + d] = (bf16)f2bf(x2 * c + x1 * s); } }
        { const int t = m & (SEQ - 1);
#pragma unroll
          for (int i = 0; i < 8; ++i) { const int ch = lane + 64 * i;
              const float u0 = bf2f(row[P_GC + ch]) * bf2f(row[P_H + ch]);
              const float u1 = t >= 1 ? bf2f(row[P_GC + ch - LDP]) * bf2f(row[P_H + ch - LDP]) : 0.f;
              const float u2 = t >= 2 ? bf2f(row[P_GC + ch - 2 * LDP]) * bf2f(row[P_H + ch - 2 * LDP]) : 0.f;
              const float y = convw[ch] * u2 + convw[512 + ch] * u1 + convw[1024 + ch] * u0;
              ymix[(size_t)m * D + Y_A + ch] = (bf16)f2bf(bf2f(row[P_GB + ch]) * y); } }
    }
}

__device__ __forceinline__ int crow(int r, int hi) { return (r & 3) + 8 * (r >> 2) + 4 * hi; }
constexpr int VROW = 320;
constexpr int VTILE = 32 * VROW;
struct AttnSt { f32x16 o[4]; float m, l; };
__device__ __forceinline__ void attn_init(AttnSt& st) {
#pragma unroll
    for (int d = 0; d < 4; ++d)
#pragma unroll
        for (int r = 0; r < 16; ++r) st.o[d][r] = 0.f;
    st.m = -1e30f; st.l = 0.f;
}
__device__ __forceinline__ s16x4 vtr(const LAS unsigned char* p) { return __builtin_bit_cast(s16x4, __builtin_amdgcn_ds_read_tr16_b64_v4i16((LAS s16x4*)p)); }
__device__ __forceinline__ void attn_tile(AttnSt& st, const bf16x8 (&qf)[8], const bf16* kp, const bf16* vp, LAS unsigned char* vl, unsigned vmask, int lane) {
    const int r32 = lane & 31, hi = lane >> 5;
    bf16x8 kf[8], vv[4];
#pragma unroll
    for (int ks = 0; ks < 8; ++ks) kf[ks] = *(const bf16x8*)(kp + ks * 16);
#pragma unroll
    for (int i = 0; i < 4; ++i) vv[i] = *(const bf16x8*)(vp + i * 16);
    f32x16 s;
#pragma unroll
    for (int r = 0; r < 16; ++r) s[r] = 0.f;
#pragma unroll
    for (int ks = 0; ks < 8; ++ks) s = __builtin_amdgcn_mfma_f32_32x32x16_bf16(kf[ks], qf[ks], s, 0, 0, 0);
#pragma unroll
    for (int i = 0; i < 4; ++i) *(LAS bf16x8*)(vl + r32 * VROW + (hi + 2 * i) * 16) = vv[i];
    asm volatile("" ::: "memory");
#pragma unroll
    for (int i = 0; i < 4; ++i) vv[i] = *(const bf16x8*)(vp + (i + 4) * 16);
#pragma unroll
    for (int i = 0; i < 4; ++i) *(LAS bf16x8*)(vl + r32 * VROW + (hi + 2 * (i + 4)) * 16) = vv[i];
    float mx = -INFINITY;
#pragma unroll
    for (int r = 0; r < 16; ++r) { s[r] = ((vmask >> r) & 1u) ? s[r] : -INFINITY; mx = fmaxf(mx, s[r]); }
    mx = fmaxf(mx, __shfl_xor(mx, 32));
    const float mn = fmaxf(st.m, mx), alpha = __builtin_amdgcn_exp2f((st.m - mn) * SM_C), mc = -mn * SM_C;
    st.m = mn;
    float ps = 0.f;
#pragma unroll
    for (int r = 0; r < 16; ++r) { s[r] = __builtin_amdgcn_exp2f(fmaf(s[r], SM_C, mc)); ps += s[r]; }
    st.l = st.l * alpha + ps;
#pragma unroll
    for (int d = 0; d < 4; ++d) st.o[d] = st.o[d] * alpha;
    bf16x8 pf[2];
#pragma unroll
    for (int sx = 0; sx < 2; ++sx) { v4u w; w.x = pk2(s[8 * sx + 0], s[8 * sx + 1]); w.y = pk2(s[8 * sx + 2], s[8 * sx + 3]); w.z = pk2(s[8 * sx + 4], s[8 * sx + 5]); w.w = pk2(s[8 * sx + 6], s[8 * sx + 7]); pf[sx] = __builtin_bit_cast(bf16x8, w); }
    const int g4 = lane >> 4, qq = (lane >> 2) & 3, pp = lane & 3;
    const LAS unsigned char* vb = vl + (4 * (g4 >> 1) + qq) * VROW + (16 * (g4 & 1) + 4 * pp) * 2;
#pragma unroll
    for (int d = 0; d < 4; ++d)
#pragma unroll
        for (int sx = 0; sx < 2; ++sx) { const s16x4 lo = vtr(vb + (16 * sx) * VROW + 64 * d), h8 = vtr(vb + (16 * sx + 8) * VROW + 64 * d);
            const bf16x8 a = (bf16x8){lo[0], lo[1], lo[2], lo[3], h8[0], h8[1], h8[2], h8[3]};
            st.o[d] = __builtin_amdgcn_mfma_f32_32x32x16_bf16(a, pf[sx], st.o[d], 0, 0, 0); }
}

__device__ __forceinline__ void indexer_unit(Frame& F, const bf16* proj, float* scores, int b, int tt, int kc) {
    const int lane = F.lane, r32 = lane & 31, hi = lane >> 5;
    const int t0 = tt * 64 + F.wave * 8;
    bf16x8 qa[4][4]; float wv[4][16];
    { const int tsel = (r32 >> 2) & 1, head = 4 * (r32 >> 3) + (r32 & 3);
#pragma unroll
      for (int a = 0; a < 4; ++a) { const bf16* qp = proj + (size_t)(b * SEQ + t0 + 2 * a + tsel) * LDP + P_QI + head * 64 + hi * 8;
#pragma unroll
          for (int ks = 0; ks < 4; ++ks) qa[a][ks] = *(const bf16x8*)(qp + ks * 16);
          const v4u* wp = (const v4u*)(proj + (size_t)(b * SEQ + t0 + 2 * a + hi) * LDP + P_WI); const v4u w0 = wp[0], w1 = wp[1];
          const unsigned ww[8] = {w0.x, w0.y, w0.z, w0.w, w1.x, w1.y, w1.z, w1.w};
#pragma unroll
          for (int j = 0; j < 8; ++j) { wv[a][2 * j] = 0.25f * bf_lo(ww[j]); wv[a][2 * j + 1] = 0.25f * bf_hi(ww[j]); } } }
    for (int kt = 0; kt < 8; ++kt) {
        const int k0 = kc * 256 + kt * 32;
        const bf16* kp = proj + (size_t)(b * SEQ + k0 + r32) * LDP + P_KI + hi * 8;
        bf16x8 kf[4];
#pragma unroll
        for (int ks = 0; ks < 4; ++ks) kf[ks] = *(const bf16x8*)(kp + ks * 16);
#pragma unroll
        for (int a = 0; a < 4; ++a) { f32x16 acc;
#pragma unroll
            for (int r = 0; r < 16; ++r) acc[r] = 0.f;
#pragma unroll
            for (int ks = 0; ks < 4; ++ks) acc = __builtin_amdgcn_mfma_f32_32x32x16_bf16(qa[a][ks], kf[ks], acc, 0, 0, 0);
            float sc = 0.f;
#pragma unroll
            for (int r = 0; r < 16; ++r) sc = fmaf(wv[a][r], fmaxf(acc[r], 0.f), sc);
            scores[(size_t)(b * SEQ + t0 + 2 * a + hi) * SEQ + k0 + r32] = sc; }
    }
}
__device__ __forceinline__ void dilated_unit(Frame& F, const bf16* proj, bf16* ymix, float* lse, int wu) {
    const int lane = F.lane, r32 = lane & 31, hi = lane >> 5;
    const int b = wu / 768; int rem = wu % 768; const int g = rem >> 8; rem &= 255; const int hh = rem >> 7, ti = rem & 127;
    const int sh = 2 * g, dl = 1 << sh, tpc = 128 >> sh;
    const int r = ti / tpc, i0 = (ti % tpc) * 32, hd = g * 2 + hh;
    LAS unsigned char* vl = F.lds + F.wave * VTILE;
    const int tq = r + dl * (i0 + r32);
    bf16x8 qf[8];
    { const bf16* qp = proj + (size_t)(b * SEQ + tq) * LDP + P_QC + hd * 128 + hi * 8;
#pragma unroll
      for (int ks = 0; ks < 8; ++ks) qf[ks] = *(const bf16x8*)(qp + ks * 16); }
    AttnSt st; attn_init(st);
    for (int kt = 0; kt < 5; ++kt) {
        const int ib = i0 - 128 + 32 * kt;
        if (ib + 31 < 0) continue;
        const int ik = ib + r32, ikc = ik < 0 ? 0 : ik;
        const bf16* rowp = proj + (size_t)(b * SEQ + r + dl * ikc) * LDP + hd * 128 + hi * 8;
        unsigned vmask = 0u; const int iq = i0 + r32;
#pragma unroll
        for (int rr = 0; rr < 16; ++rr) { const int ikey = ib + crow(rr, hi); vmask |= (ikey >= 0 && ikey <= iq && ikey >= iq - 128) ? (1u << rr) : 0u; }
        attn_tile(st, qf, rowp + P_KC, rowp + P_VC, vl, vmask, lane);
    }
    const float lt = st.l + __shfl_xor(st.l, 32), inv = 1.0f / lt;
    bf16* op = ymix + (size_t)(b * SEQ + tq) * D + Y_C + hd * 128;
#pragma unroll
    for (int d = 0; d < 4; ++d)
#pragma unroll
        for (int r4 = 0; r4 < 4; ++r4) { v2u w; w.x = pk2(st.o[d][4 * r4] * inv, st.o[d][4 * r4 + 1] * inv); w.y = pk2(st.o[d][4 * r4 + 2] * inv, st.o[d][4 * r4 + 3] * inv);
            *(v2u*)(op + 32 * d + 8 * r4 + 4 * hi) = w; }
    if (hi == 0) lse[(size_t)(b * SEQ + tq) * 6 + hd] = st.m * SM_C + __builtin_amdgcn_logf(lt);
}
constexpr int N_IDX_UNITS = 2 * 544, N_DIL_WU = 2 * 3 * 2 * 128, N_P6_UNITS = N_IDX_UNITS + N_DIL_WU / NWAVES;
__device__ __forceinline__ void p6_phase(Frame& F, const bf16* proj, bf16* ymix, float* scores, float* lse) {
    for (int u = F.bid; u < N_P6_UNITS; u += F.G) {
        if (u < N_IDX_UNITS) { const int b = u / 544; int r = u % 544; int q = 0; while (r >= 4 * (q + 1)) { r -= 4 * (q + 1); ++q; }
            const int tt = 4 * q + r / (q + 1), kc = r % (q + 1);
            indexer_unit(F, proj, scores, b, tt, kc); }
        else dilated_unit(F, proj, ymix, lse, (u - N_IDX_UNITS) * NWAVES + F.wave);
    }
}

__device__ __forceinline__ unsigned f2ord(float f) { const unsigned b = __builtin_bit_cast(unsigned, f); return b ^ ((unsigned)((int)b >> 31) | 0x80000000u); }
__device__ __forceinline__ void p7_phase(Frame& F, const bf16* proj, bf16* ymix, const float* scores, const float* lse) {
    const int lane = F.lane, r32 = lane & 31, hi = lane >> 5;
    LAS unsigned char* vl = F.lds + F.wave * VTILE;
    LAS int* list = (LAS int*)(F.lds + NWAVES * VTILE + F.wave * 1024);
    for (int m = F.gw; m < M; m += F.NGW) {
        const int b = m / SEQ, t = m % SEQ;
        { float ls[6];
#pragma unroll
          for (int i = 0; i < 6; ++i) ls[i] = lse[(size_t)m * 6 + i];
          unsigned* yc = (unsigned*)(ymix + (size_t)m * D + Y_C);
#pragma unroll
          for (int hh = 0; hh < 2; ++hh) { const float mx = fmaxf(ls[hh], fmaxf(ls[2 + hh], ls[4 + hh]));
              const float e0 = __builtin_amdgcn_exp2f(ls[hh] - mx), e1 = __builtin_amdgcn_exp2f(ls[2 + hh] - mx), e2 = __builtin_amdgcn_exp2f(ls[4 + hh] - mx), rs = 1.0f / (e0 + e1 + e2);
              const float al[3] = {e0 * rs, e1 * rs, e2 * rs};
#pragma unroll
              for (int g = 0; g < 3; ++g) { const int idx = (g * 2 + hh) * 64 + lane; const unsigned w = yc[idx]; yc[idx] = pk2(bf_lo(w) * al[g], bf_hi(w) * al[g]); } } }
        const float* srow = scores + (size_t)m * SEQ;
        unsigned u[64];
        { const float* sp = srow + lane;
#pragma unroll
          for (int g8 = 0; g8 < 8; ++g8) {
              if (g8 * 512 <= t) {
#pragma unroll
                  for (int jj = 0; jj < 8; ++jj) { const int j = g8 * 8 + jj; const float v = sp[j * 64]; u[j] = (j * 64 + lane <= t) ? f2ord(v) : 0u; }
              } else {
#pragma unroll
                  for (int jj = 0; jj < 8; ++jj) u[g8 * 8 + jj] = 0u;
              } } }
        unsigned T = 0u; int need = 0;
        if (t + 1 > 256) {
            bool exact = false;
            for (int bit = 31; bit >= 0; --bit) {
                const unsigned cand = T | (1u << bit); int cnt = 0;
#pragma unroll
                for (int j = 0; j < 64; ++j) cnt += __popcll(__ballot(u[j] >= cand));
                if (cnt >= 256) { T = cand; if (cnt == 256) { exact = true; break; } }
            }
            if (exact) need = 0x7fffffff;
            else { int ngt = 0;
#pragma unroll
                for (int j = 0; j < 64; ++j) ngt += __popcll(__ballot(u[j] > T));
                need = 256 - ngt; }
        }
        int nsel = 0, eqtaken = 0;
#pragma unroll
        for (int j = 0; j < 64; ++j) {
            const bool gt = u[j] > T, eq = (u[j] == T) && (T != 0u);
            const unsigned long long meq = __ballot(eq);
            const int eqrank = eqtaken + __popcll(meq & ((1ull << lane) - 1ull));
            const bool take = gt || (eq && eqrank < need);
            const unsigned long long mt = __ballot(take);
            if (take) list[nsel + __popcll(mt & ((1ull << lane) - 1ull))] = j * 64 + lane;
            nsel += __popcll(mt); eqtaken += __popcll(meq);
        }
        bf16x8 qf[8];
        { const bf16* qp = proj + (size_t)m * LDP + P_QB + (r32 < 6 ? r32 : 0) * 128 + hi * 8;
#pragma unroll
          for (int ks = 0; ks < 8; ++ks) { qf[ks] = *(const bf16x8*)(qp + ks * 16); if (r32 >= 6) qf[ks] = (bf16x8){0, 0, 0, 0, 0, 0, 0, 0}; } }
        AttnSt st; attn_init(st);
        const int ntile = (nsel + 31) >> 5;
        for (int kt = 0; kt < ntile; ++kt) {
            const int slot = kt * 32 + r32; const int key = slot < nsel ? list[slot] : 0;
            const bf16* rowp = proj + (size_t)(b * SEQ + key) * LDP + hi * 8;
            unsigned vmask = 0u;
#pragma unroll
            for (int rr = 0; rr < 16; ++rr) vmask |= (kt * 32 + crow(rr, hi) < nsel) ? (1u << rr) : 0u;
            attn_tile(st, qf, rowp + P_KB, rowp + P_VB, vl, vmask, lane);
        }
        const float lt = st.l + __shfl_xor(st.l, 32), inv = 1.0f / lt;
        if (r32 < 6) { bf16* op = ymix + (size_t)m * D + Y_B + r32 * 128;
#pragma unroll
            for (int d = 0; d < 4; ++d)
#pragma unroll
                for (int r4 = 0; r4 < 4; ++r4) { v2u w; w.x = pk2(st.o[d][4 * r4] * inv, st.o[d][4 * r4 + 1] * inv); w.y = pk2(st.o[d][4 * r4 + 2] * inv, st.o[d][4 * r4 + 3] * inv);
                    *(v2u*)(op + 32 * d + 8 * r4 + 4 * hi) = w; } }
    }
}

constexpr int PH_PRO = 0, PH_PER_LAYER = 12, PH_FINAL = 1 + DEPTH * PH_PER_LAYER, N_PHASES = PH_FINAL + 1;
__global__ void __launch_bounds__(NWAVES * 64, 2) fwd_kernel(Args args) {
    extern __shared__ __attribute__((aligned(16))) unsigned char lds[];
    Frame F;
    F.lds = (LAS unsigned char*)lds; F.tid = threadIdx.x; F.lane = F.tid & 63; F.wave = __builtin_amdgcn_readfirstlane(F.tid >> 6); F.bid = blockIdx.x;
    const int wave0 = F.wave;
    F.G = gridDim.x; F.gw = blockIdx.x * NWAVES + F.wave; F.NGW = F.G * NWAVES; F.ws = args.ws;
    volatile LAS unsigned* MISC = (volatile LAS unsigned*)(F.lds + MISC_OFF);
    for (int i = F.tid; i < (LDS_BYTES - RING_BYTES) / 4; i += NWAVES * 64) ((LAS unsigned*)(F.lds + RING_BYTES))[i] = 0u;
    __syncthreads();
    const int lo = args.ph_lo, hi = args.ph_hi;
    XcdBarrier bar; bar.bar = (unsigned*)(args.ws + WS_CTL) + CW_BAR; bar.x = 0; bar.st = nullptr;
    if (hi - lo > 1) bar = xcd_barrier_post((unsigned*)(args.ws + WS_CTL) + CW_BAR, MISC + 8);
#define IN(k) (lo <= (k) && (k) < hi)
#ifndef PHMASK
#define PHMASK 0xFFFF
#endif
#define PHM(b) ((PHMASK >> (b)) & 1)
#define RELANE() do { int w_ = wave0, b_ = blockIdx.x; asm volatile("" : "+s"(w_), "+s"(b_)); int l_; asm volatile("v_mbcnt_lo_u32_b32 %0, -1, 0\n\tv_mbcnt_hi_u32_b32 %0, -1, %0" : "=v"(l_)); F.wave = w_; F.bid = b_; F.lane = l_; F.tid = w_ * 64 + l_; F.gw = b_ * NWAVES + w_; } while (0)
#define SEAM(k) do { if (IN(k) && IN((k) + 1)) xcd_barrier(bar); } while (0)
    float* X = args.out;
    bf16* XN = (bf16*)(args.ws + WS_XN); bf16* YMIX = (bf16*)(args.ws + WS_YMIX); bf16* HB = (bf16*)(args.ws + WS_H); bf16* PROJ = (bf16*)(args.ws + WS_PROJ);
    float* SCORES = (float*)(args.ws + WS_SCORES); float* LSE = (float*)(args.ws + WS_LSE);

    if (PHM(0) && IN(PH_PRO)) { RELANE(); prologue(F, args); } SEAM(PH_PRO);

    for (int L = 0; L < DEPTH; ++L) {
        const int pb = 1 + L * PH_PER_LAYER;
        if (hi <= pb || lo >= pb + PH_PER_LAYER) continue;
        unsigned char* wl = args.ws + WS_W + (size_t)L * WL_STRIDE;
        if (PHM(1) && IN(pb + 0)) { RELANE(); norm_phase(F, L == 0 ? IN_X : X, IN_N1 + L * D, XN); } SEAM(pb + 0);
        if (PHM(2) && IN(pb + 1)) { RELANE(); pg8::Gemm g{XN, (const bf16*)(wl + WL_GU1), M, 2 * FF, D}; pg8::StaticOrder S; S.init(M, 2 * FF, F.G, F.bid); pg8::EpiSwiglu E{HB, FF};
            pg8::gemm_phase<pg8::EpiSwiglu, pg8::StaticOrder, true, true>(F.lds, g, S, E, F.tid); } SEAM(pb + 1);
        if (PHM(3) && IN(pb + 2)) { RELANE(); pg8::Gemm g{HB, (const bf16*)(wl + WL_D1), M, D, FF}; pg8::StaticOrder S; S.init(M, D, F.G, F.bid); pg8::EpiResid E{L == 0 ? IN_X : X, X, D, 0.5f};
            pg8::gemm_phase<pg8::EpiResid, pg8::StaticOrder, true, true>(F.lds, g, S, E, F.tid); } SEAM(pb + 2);
        if (PHM(1) && IN(pb + 3)) { RELANE(); norm_phase(F, X, IN_NM + L * D, XN); } SEAM(pb + 3);
        if (PHM(4) && IN(pb + 4)) { RELANE(); pg8::Gemm g{XN, (const bf16*)(wl + WL_IN), M, LDP, D}; pg8::StaticOrder S; S.init(M, LDP, F.G, F.bid); pg8::EpiStoreBf16 E{PROJ, LDP};
            pg8::gemm_phase<pg8::EpiStoreBf16, pg8::StaticOrder, true, true>(F.lds, g, S, E, F.tid); } SEAM(pb + 4);
        if (PHM(5) && IN(pb + 5)) { RELANE(); rope_conv_phase(F, PROJ, YMIX, IN_CW + L * 3 * 512); } SEAM(pb + 5);
        if (PHM(6) && IN(pb + 6)) { RELANE(); p6_phase(F, PROJ, YMIX, SCORES, LSE); } SEAM(pb + 6);
        if (PHM(7) && IN(pb + 7)) { RELANE(); p7_phase(F, PROJ, YMIX, SCORES, LSE); } SEAM(pb + 7);
        if (PHM(8) && IN(pb + 8)) { RELANE(); pg8::Gemm g{YMIX, (const bf16*)(wl + WL_OUT), M, D, D}; pg8::StaticOrder S; S.init(M, D, F.G, F.bid); pg8::EpiResid E{X, X, D, 1.0f};
            pg8::gemm_phase<pg8::EpiResid, pg8::StaticOrder, true, true>(F.lds, g, S, E, F.tid); } SEAM(pb + 8);
        if (PHM(1) && IN(pb + 9)) { RELANE(); norm_phase(F, X, IN_N2 + L * D, XN); } SEAM(pb + 9);
        if (PHM(2) && IN(pb + 10)) { RELANE(); pg8::Gemm g{XN, (const bf16*)(wl + WL_GU2), M, 2 * FF, D}; pg8::StaticOrder S; S.init(M, 2 * FF, F.G, F.bid); pg8::EpiSwiglu E{HB, FF};
            pg8::gemm_phase<pg8::EpiSwiglu, pg8::StaticOrder, true, true>(F.lds, g, S, E, F.tid); } SEAM(pb + 10);
        if (PHM(3) && IN(pb + 11)) { RELANE(); pg8::Gemm g{HB, (const bf16*)(wl + WL_D2), M, D, FF}; pg8::StaticOrder S; S.init(M, D, F.G, F.bid); pg8::EpiResid E{X, X, D, 0.5f};
            pg8::gemm_phase<pg8::EpiResid, pg8::StaticOrder, true, true>(F.lds, g, S, E, F.tid); } SEAM(pb + 11);
    }
    if (PHM(9) && IN(PH_FINAL)) { RELANE(); final_norm_phase(F, X, IN_NF); }
#undef IN
#undef SEAM
}

#ifndef MK_PER_PHASE
#define MK_PER_PHASE 0
#endif
extern "C" void kernel_launch(void* const* d_in, const int* in_sizes, int n_in, void* d_out, int out_size, void* d_ws, size_t ws_size, hipStream_t stream) {
    static int grid = 0;
    if (grid == 0) {
        if (n_in != 15 || out_size != M * D || ws_size < WS_END) { fprintf(stderr, "kernel_launch: unexpected shapes (n_in %d, out %d, ws %zu < %zu); nothing launched\n", n_in, out_size, ws_size, (size_t)WS_END); grid = -1; return; }
        int dev = 0, cus = 0, per_cu = 0;
        if (hipGetDevice(&dev) != hipSuccess || hipDeviceGetAttribute(&cus, hipDeviceAttributeMultiprocessorCount, dev) != hipSuccess) { grid = -1; return; }
        if (hipFuncSetAttribute((const void*)fwd_kernel, hipFuncAttributeMaxDynamicSharedMemorySize, LDS_BYTES) != hipSuccess) { fprintf(stderr, "kernel_launch: hipFuncSetAttribute failed\n"); grid = -1; return; }
        if (hipOccupancyMaxActiveBlocksPerMultiprocessor(&per_cu, (const void*)fwd_kernel, NWAVES * 64, LDS_BYTES) != hipSuccess || per_cu < 1) fprintf(stderr, "kernel_launch: occupancy query says %d\n", per_cu);
        (void)hipGetLastError();
        grid = cus;
    }
    if (grid < 0) return;
    if (hipMemsetAsync((char*)d_ws + WS_CTL, 0, CTL_ZERO_BYTES, stream) != hipSuccess) return;
    Args a{};
    for (int i = 0; i < 15; ++i) a.in[i] = d_in[i];
    a.out = (float*)d_out; a.ws = (unsigned char*)d_ws;
#if MK_PER_PHASE
    for (int p = 0; p < N_PHASES; ++p) { a.ph_lo = p; a.ph_hi = p + 1; hipLaunchKernelGGL(fwd_kernel, dim3(grid), dim3(NWAVES * 64), LDS_BYTES, stream, a); }
#else
    a.ph_lo = 0; a.ph_hi = N_PHASES;
    hipLaunchKernelGGL(fwd_kernel, dim3(grid), dim3(NWAVES * 64), LDS_BYTES, stream, a);
#endif
}
```

```cpp
#include <hip/hip_runtime.h>
#include <cstdio>
#include <cstdint>
namespace pg8 {
#define PG8_LAS __attribute__((address_space(3)))
typedef unsigned short bf16_t;
typedef short bf16x8 __attribute__((ext_vector_type(8)));
typedef float f32x4 __attribute__((ext_vector_type(4)));
typedef unsigned u32x4 __attribute__((ext_vector_type(4)));
constexpr int BM = 256, BK = 64, HALF = 128, HTB = HALF * BK * 2  , STAGE_BYTES = 8 * HTB, NXCD = 8, WGM = 8;

__host__ __device__ __forceinline__ int lds_byte(int r, int c) { const int st = (r >> 4) * 2 + (c >> 5), rr = r & 15, cc = c & 31, ob = rr * 64 + cc * 2; return st * 1024 + (ob ^ (((ob >> 9) & 1) << 5)); }
__host__ __device__ __forceinline__ void stage_rc(int b, int& R, int& C) { const int st = b / 1024, sb = b % 1024, swz = sb ^ (((sb >> 9) & 1) << 5); R = (st >> 1) * 16 + swz / 64; C = (st & 1) * 32 + (swz % 64) / 2; }
__host__ __device__ __forceinline__ int perm32(int rho) { const int n = rho >> 4, i = rho & 15; return 8 * (i >> 2) + 4 * n + (i & 3); }

struct Unit { int pm, pn; };
struct Gemm { const bf16_t* A; const bf16_t* Bt; int M, N, K; };

struct StaticOrder {
    int nM, nN, nwg, G, c;
    __host__ __device__ void init(int M, int N, int G_, int c_) { nM = M / BM; nN = N / BM; nwg = nM * nN; G = G_; c = c_; }
    __host__ __device__ bool next(int i, Unit& u) const {
        const long L = (long)i * G + c; if (L >= nwg) return false;
        int wgid = (int)L; { const int q = nwg / NXCD, r = nwg % NXCD, xcd = wgid % NXCD, off = wgid / NXCD; wgid = (xcd < r ? xcd * (q + 1) : r * (q + 1) + (xcd - r) * q) + off; }
        const int nig = WGM * nN, gid = wgid / nig, fm = gid * WGM, gsz = (nM - fm) < WGM ? (nM - fm) : WGM;
        u.pm = fm + ((wgid % nig) % gsz); u.pn = (wgid % nig) / gsz; return true;
    }
    __device__ __forceinline__ void a_ready(const Unit&) const {}
    __device__ __forceinline__ void done(const Unit&) const {}
};

__device__ __forceinline__ unsigned cvt_pk_bf16(float lo, float hi) { unsigned r; asm volatile("v_cvt_pk_bf16_f32 %0, %1, %2" : "=v"(r) : "v"(lo), "v"(hi)); return r; }
typedef float f32x2 __attribute__((ext_vector_type(2)));
struct EpiStoreBf16 {
    static constexpr bool PERM = true, AFTER_DRAIN = false;
    bf16_t* O; int ldc;
    __device__ __forceinline__ void operator()(const f32x4 (&acc)[2][2][4][2], const Unit& u, int wr, int wc, int fr, int fq) const {
        const int row0 = u.pm * BM + wr * 64 + fr, col0 = u.pn * BM + wc * 32 + 8 * fq;
#pragma unroll
        for (int ai = 0; ai < 2; ++ai)
#pragma unroll
            for (int m = 0; m < 4; ++m) { bf16_t* rowp = O + (size_t)(row0 + ai * HALF + m * 16) * ldc + col0;
#pragma unroll
                for (int bj = 0; bj < 2; ++bj) { const f32x4 v0 = acc[ai][bj][m][0], v1 = acc[ai][bj][m][1];
                    u32x4 w; w.x = cvt_pk_bf16(v0[0], v0[1]); w.y = cvt_pk_bf16(v0[2], v0[3]); w.z = cvt_pk_bf16(v1[0], v1[1]); w.w = cvt_pk_bf16(v1[2], v1[3]);
                    *(u32x4*)(rowp + bj * HALF) = w; } }
    }
};
struct EpiSwiglu {
    static constexpr bool PERM = true, AFTER_DRAIN = false;
    bf16_t* H; int ldh;
    __device__ __forceinline__ static float silu_mul(float g, float u) { return g * u * __builtin_amdgcn_rcpf(1.0f + __builtin_amdgcn_exp2f(-1.4426950408889634f * g)); }
    __device__ __forceinline__ void operator()(const f32x4 (&acc)[2][2][4][2], const Unit& u, int wr, int wc, int fr, int fq) const {
        const int row0 = u.pm * BM + wr * 64 + fr, col0 = u.pn * HALF + wc * 32 + 8 * fq;
#pragma unroll
        for (int ai = 0; ai < 2; ++ai)
#pragma unroll
            for (int m = 0; m < 4; ++m) { bf16_t* rowp = H + (size_t)(row0 + ai * HALF + m * 16) * ldh + col0;
                const f32x4 g0 = acc[ai][0][m][0], g1 = acc[ai][0][m][1], u0 = acc[ai][1][m][0], u1 = acc[ai][1][m][1];
                u32x4 w;
                w.x = cvt_pk_bf16(silu_mul(g0[0], u0[0]), silu_mul(g0[1], u0[1])); w.y = cvt_pk_bf16(silu_mul(g0[2], u0[2]), silu_mul(g0[3], u0[3]));
                w.z = cvt_pk_bf16(silu_mul(g1[0], u1[0]), silu_mul(g1[1], u1[1])); w.w = cvt_pk_bf16(silu_mul(g1[2], u1[2]), silu_mul(g1[3], u1[3]));
                *(u32x4*)rowp = w; }
    }
};
struct EpiResid {
    static constexpr bool PERM = false, AFTER_DRAIN = false;
    const float* src; float* dst; int ldc; float scale;
    __device__ __forceinline__ void operator()(const f32x4 (&acc)[2][2][4][2], const Unit& u, int wr, int wc, int fr, int fq) const {
        const int row0 = u.pm * BM + wr * 64 + fr, col0 = u.pn * BM + wc * 32 + 4 * fq;
#pragma unroll
        for (int ai = 0; ai < 2; ++ai)
#pragma unroll
            for (int m = 0; m < 4; ++m) { const size_t off = (size_t)(row0 + ai * HALF + m * 16) * ldc + col0;
#pragma unroll
                for (int bj = 0; bj < 2; ++bj)
#pragma unroll
                    for (int n = 0; n < 2; ++n) { const f32x4 b = *(const f32x4*)(src + off + bj * HALF + n * 16); *(f32x4*)(dst + off + bj * HALF + n * 16) = b + acc[ai][bj][m][n] * scale; }
                asm volatile("" ::: "memory"); }
    }
};
template <class Epi, class Sched, bool ALIGN_EPI = false, bool SP2 = false>
__device__ __forceinline__ void gemm_phase(PG8_LAS unsigned char* lds, const Gemm g, const Sched& S, const Epi& E, const int tid_in  ) {
    const int tid = tid_in, wid = __builtin_amdgcn_readfirstlane(tid >> 6), lane = tid & 63, wr = wid >> 2, wc = wid & 3, fr = lane & 15, fq = lane >> 4;
    const int K = g.K, nt = K / BK;
    unsigned voffA[2], voffB[2];
#pragma unroll
    for (int i = 0; i < 2; ++i) { int R, C; stage_rc(tid * 16 + i * 8192, R, C); const int Rb = Epi::PERM ? ((R & ~31) + perm32(R & 31)) : R;
        voffA[i] = (unsigned)(R * K + C) * 2u; voffB[i] = (unsigned)(Rb * K + C) * 2u; }
    const size_t kstep = (size_t)(BK * 2);
    const size_t hstep = (size_t)HALF * K * 2;
    const size_t tstep = 2 * hstep;
    const unsigned ldsw = (unsigned)wid * 1024u;
    const int aoff = lds_byte(wr * 64 + fr, fq * 8), boff = lds_byte(wc * 32 + fr, fq * 8);
#define PG8_SA(b, h) (((b) * 2 + (h)) * HTB)
#define PG8_SB(b, h) ((4 + (b) * 2 + (h)) * HTB)
#define PG8_STAGE(bufoff, gbase, voff) do { _Pragma("unroll") for (int _i = 0; _i < 2; ++_i) \
        __builtin_amdgcn_global_load_lds((const unsigned*)((const char*)(gbase) + (voff)[_i]), (PG8_LAS unsigned*)(lds + (bufoff) + ldsw + _i * 8192), 16, 0, 0); } while (0)
#define PG8_LDA(dst, b, h) do { _Pragma("unroll") for (int m = 0; m < 4; ++m) _Pragma("unroll") for (int k = 0; k < 2; ++k) dst[m][k] = *(const PG8_LAS bf16x8*)(lds + PG8_SA(b, h) + aoff + m * 2048 + k * 1024); } while (0)
#define PG8_LDB(dst, b, h) do { _Pragma("unroll") for (int n = 0; n < 2; ++n) _Pragma("unroll") for (int k = 0; k < 2; ++k) dst[n][k] = *(const PG8_LAS bf16x8*)(lds + PG8_SB(b, h) + boff + n * 2048 + k * 1024); } while (0)
#define PG8_MMA(ai, bj, At, Bt) do { __builtin_amdgcn_s_setprio(1); _Pragma("unroll") for (int m = 0; m < 4; ++m) _Pragma("unroll") for (int n = 0; n < 2; ++n) _Pragma("unroll") for (int k = 0; k < 2; ++k) \
        acc[ai][bj][m][n] = __builtin_amdgcn_mfma_f32_16x16x32_bf16(Bt[n][k], At[m][k], acc[ai][bj][m][n], 0, 0, 0); __builtin_amdgcn_s_setprio(0); } while (0)
#define PG8_WAIT_V(n) asm volatile("s_waitcnt vmcnt(" #n ")" ::: "memory")
#define PG8_WAIT_L(n) asm volatile("s_waitcnt lgkmcnt(" #n ")" ::: "memory")
#define PG8_BAR __builtin_amdgcn_s_barrier()
#define PG8_SCHED __builtin_amdgcn_sched_barrier(0)
    Unit cur, nxt; int ui = 0;
    if (!S.next(0, cur)) return;
    f32x4 acc[2][2][4][2];
#pragma unroll
    for (int a = 0; a < 2; ++a)
#pragma unroll
        for (int b = 0; b < 2; ++b)
#pragma unroll
            for (int m = 0; m < 4; ++m)
#pragma unroll
                for (int n = 0; n < 2; ++n) acc[a][b][m][n] = (f32x4){0.f, 0.f, 0.f, 0.f};
    bf16x8 At[4][2], B0[2][2], B1[2][2];
    const char* cA = (const char*)g.A + (size_t)cur.pm * tstep; const char* cB = (const char*)g.Bt + (size_t)cur.pn * tstep;
    S.a_ready(cur);
    if constexpr (SP2) {
        PG8_STAGE(PG8_SB(0, 0), cB, voffB); PG8_STAGE(PG8_SB(0, 1), cB + hstep, voffB); PG8_STAGE(PG8_SA(0, 0), cA, voffA); PG8_STAGE(PG8_SA(0, 1), cA + hstep, voffA);
        if (wr == 1) PG8_BAR;
        PG8_WAIT_V(2); PG8_BAR;
        PG8_STAGE(PG8_SB(1, 0), cB + kstep, voffB); PG8_STAGE(PG8_SA(1, 0), cA + kstep, voffA); PG8_STAGE(PG8_SB(1, 1), cB + hstep + kstep, voffB);
        PG8_WAIT_V(6); PG8_BAR;
    } else {
        PG8_STAGE(PG8_SB(0, 0), cB, voffB); PG8_STAGE(PG8_SA(0, 0), cA, voffA); PG8_STAGE(PG8_SB(0, 1), cB + hstep, voffB); PG8_STAGE(PG8_SA(0, 1), cA + hstep, voffA);
        if (wr == 1) PG8_BAR;
        PG8_WAIT_V(4); PG8_BAR;
        PG8_STAGE(PG8_SB(1, 0), cB + kstep, voffB); PG8_STAGE(PG8_SA(1, 0), cA + kstep, voffA); PG8_STAGE(PG8_SB(1, 1), cB + hstep + kstep, voffB);
        PG8_WAIT_V(6); PG8_BAR;
    }
    for (;;) {
        const bool has_next = S.next(ui + 1, nxt);
        const char* nA = has_next ? (const char*)g.A + (size_t)nxt.pm * tstep : cA; const char* nB = has_next ? (const char*)g.Bt + (size_t)nxt.pn * tstep : cB;
        for (int t = 0; t < nt; t += 2) {
            const bool last = (t == nt - 2);
            const char* a1 = cA + (size_t)(t + 1) * kstep;
            const char* a2 = last ? nA : cA + (size_t)(t + 2) * kstep; const char* b2 = last ? nB : cB + (size_t)(t + 2) * kstep;
            const char* a3 = a2 + kstep; const char* b3 = b2 + kstep;
            if (last && has_next) S.a_ready(nxt);
            if constexpr (SP2) {
            PG8_LDB(B0, 0, 0); PG8_LDB(B1, 0, 1); PG8_SCHED; PG8_LDA(At, 0, 0); PG8_STAGE(PG8_SA(1, 1), a1 + hstep, voffA);
            PG8_WAIT_V(8); PG8_WAIT_L(0); PG8_BAR; PG8_MMA(0, 0, At, B0); PG8_MMA(0, 1, At, B1); PG8_BAR; PG8_SCHED;
            PG8_LDA(At, 0, 1); PG8_STAGE(PG8_SB(0, 0), b2, voffB); PG8_STAGE(PG8_SB(0, 1), b2 + hstep, voffB); PG8_STAGE(PG8_SA(0, 0), a2, voffA);
            PG8_WAIT_V(8); PG8_WAIT_L(0); PG8_BAR; PG8_MMA(1, 0, At, B0); PG8_MMA(1, 1, At, B1); PG8_BAR; PG8_SCHED;
            PG8_LDB(B0, 1, 0); PG8_LDB(B1, 1, 1); PG8_SCHED; PG8_LDA(At, 1, 0); PG8_STAGE(PG8_SA(0, 1), a2 + hstep, voffA);
            PG8_WAIT_V(8); PG8_WAIT_L(0); PG8_BAR; PG8_MMA(0, 0, At, B0); PG8_MMA(0, 1, At, B1); PG8_BAR; PG8_SCHED;
            PG8_LDA(At, 1, 1); PG8_STAGE(PG8_SB(1, 0), b3, voffB); PG8_STAGE(PG8_SB(1, 1), b3 + hstep, voffB); PG8_STAGE(PG8_SA(1, 0), a3, voffA);
            PG8_WAIT_V(8); PG8_WAIT_L(0); PG8_BAR; PG8_MMA(1, 0, At, B0); PG8_MMA(1, 1, At, B1); PG8_BAR; PG8_SCHED;
            } else {
            PG8_LDB(B0, 0, 0); PG8_SCHED; PG8_LDA(At, 0, 0); PG8_STAGE(PG8_SA(1, 1), a1 + hstep, voffA);
            PG8_WAIT_L(8); PG8_BAR; PG8_WAIT_L(0); PG8_MMA(0, 0, At, B0); PG8_BAR; PG8_SCHED;
            PG8_LDB(B1, 0, 1); PG8_STAGE(PG8_SB(0, 0), b2, voffB);
            PG8_BAR; PG8_WAIT_L(0); PG8_MMA(0, 1, At, B1); PG8_BAR;
            PG8_LDA(At, 0, 1); PG8_STAGE(PG8_SA(0, 0), a2, voffA);
            PG8_BAR; PG8_WAIT_L(0); PG8_MMA(1, 0, At, B0); PG8_BAR; PG8_SCHED;
            PG8_STAGE(PG8_SB(0, 1), b2 + hstep, voffB);
            PG8_WAIT_V(6); PG8_BAR; PG8_MMA(1, 1, At, B1); PG8_BAR;
            PG8_LDB(B0, 1, 0); PG8_SCHED; PG8_LDA(At, 1, 0); PG8_STAGE(PG8_SA(0, 1), a2 + hstep, voffA);
            PG8_WAIT_L(8); PG8_BAR; PG8_WAIT_L(0); PG8_MMA(0, 0, At, B0); PG8_BAR; PG8_SCHED;
            PG8_LDB(B1, 1, 1); PG8_STAGE(PG8_SB(1, 0), b3, voffB);
            PG8_BAR; PG8_WAIT_L(0); PG8_MMA(0, 1, At, B1); PG8_BAR;
            PG8_LDA(At, 1, 1); PG8_STAGE(PG8_SA(1, 0), a3, voffA);
            PG8_BAR; PG8_WAIT_L(0); PG8_MMA(1, 0, At, B0); PG8_BAR; PG8_SCHED;
            PG8_STAGE(PG8_SB(1, 1), b3 + hstep, voffB);
            PG8_WAIT_V(6); PG8_BAR; PG8_MMA(1, 1, At, B1); PG8_BAR;
            }
        }
        if constexpr (ALIGN_EPI) { if (wr == 0) PG8_BAR; }
        if constexpr (!Epi::AFTER_DRAIN) { E(acc, cur, wr, wc, fr, fq); S.done(cur); }
        if (!has_next) break;
#pragma unroll
        for (int a = 0; a < 2; ++a)
#pragma unroll
            for (int b = 0; b < 2; ++b)
#pragma unroll
                for (int m = 0; m < 4; ++m)
#pragma unroll
                    for (int n = 0; n < 2; ++n) acc[a][b][m][n] = (f32x4){0.f, 0.f, 0.f, 0.f};
        cur = nxt; cA = nA; cB = nB; ++ui;
        if constexpr (ALIGN_EPI) { if (wr == 1) PG8_BAR; }
    }
    PG8_WAIT_V(0);
    if constexpr (!ALIGN_EPI) { if (wr == 0) PG8_BAR; }
    PG8_BAR;
    if constexpr (Epi::AFTER_DRAIN) { E.fused(acc, cur, wr, wc, fr, fq, lds, wid, lane); S.done(cur); }
#undef PG8_SA
#undef PG8_SB
#undef PG8_STAGE
#undef PG8_LDA
#undef PG8_LDB
#undef PG8_MMA
#undef PG8_WAIT_V
#undef PG8_WAIT_L
#undef PG8_BAR
#undef PG8_SCHED
}
}
#define LAS __attribute__((address_space(3)))
#define XB_TMO      128
#define XB_XCNT(j)  (256  + 64 * (j))
#define XB_XSUB(j)  (1280 + 64 * (j))
#define XB_XGEN(j)  (2304 + 64 * (j))
#define XB_TOP      3328
#define XB_TOPGEN   3392
#define XCD_BAR_WORDS 3456
#define XB_SPIN_CAP (1u << 18)

__device__ __forceinline__ unsigned xb_ld(unsigned* p)              { return __hip_atomic_load(p, __ATOMIC_RELAXED, __HIP_MEMORY_SCOPE_AGENT); }
__device__ __forceinline__ unsigned xb_add(unsigned* p, unsigned v) { return __hip_atomic_fetch_add(p, v, __ATOMIC_RELAXED, __HIP_MEMORY_SCOPE_AGENT); }
__device__ __forceinline__ unsigned xb_xcc_id() { return (unsigned)__builtin_amdgcn_s_getreg((3 << 11) | 20) & 0xFu; }
#define XB_SPIN(cond, bar) do { unsigned _sp = 0; while (cond) { __builtin_amdgcn_s_sleep(1); \
    if ((++_sp & 255u) == 0u) { if (xb_ld(&(bar)[XB_TMO])) break; if (_sp > XB_SPIN_CAP) { atomicAdd(&(bar)[XB_TMO], 1u); break; } } } } while (0)

struct XcdBarrier {
    unsigned* bar; unsigned x;
    volatile LAS unsigned* st;
};

__device__ __forceinline__ XcdBarrier xcd_barrier_post(unsigned* bar, volatile LAS unsigned* st) {
    XcdBarrier b; b.bar = bar; b.x = xb_xcc_id(); b.st = st;
    if (threadIdx.x == 0) (void)xb_add(&bar[XB_XCNT(b.x)], 1u);
    return b;
}
__device__ __forceinline__ void xcd_barrier_complete(unsigned* bar, unsigned x, unsigned& nloc, unsigned& nx) {
    const unsigned G = gridDim.x * gridDim.y * gridDim.z;
    unsigned sum, cnt, mine, sp = 0u;
    for (;;) {
        sum = 0u; cnt = 0u; mine = 0u;
#pragma unroll
        for (unsigned j = 0; j < 16; ++j) { const unsigned c = xb_ld(&bar[XB_XCNT(j)]); sum += c; cnt += (c > 0u) ? 1u : 0u; mine = (j == x) ? c : mine; }
        if (sum == G) break;
        __builtin_amdgcn_s_sleep(1);
        if ((++sp & 255u) == 0u) { if (xb_ld(&bar[XB_TMO])) break; if (sp > XB_SPIN_CAP) { atomicAdd(&bar[XB_TMO], 1u); break; } }
    }
    nloc = mine > 0u ? mine : 1u; nx = cnt > 0u ? cnt : 1u;
}

__device__ __forceinline__ void xcd_barrier(const XcdBarrier& b) {
    asm volatile("s_waitcnt vmcnt(0)" ::: "memory");
    __syncthreads();
    if (threadIdx.x == 0) {
        unsigned* bar = b.bar;
        __builtin_amdgcn_s_waitcnt(0);
        unsigned nloc = b.st[0], nx = b.st[1];
        if (nloc == 0u) { xcd_barrier_complete(bar, b.x, nloc, nx); b.st[0] = nloc; b.st[1] = nx; }
        const unsigned old = xb_add(&bar[XB_XSUB(b.x)], 1u);
        const unsigned gen = old / nloc;
        if (old + 1u == (gen + 1u) * nloc) {
            __builtin_amdgcn_fence(__ATOMIC_RELEASE, "agent");
            asm volatile("s_waitcnt vmcnt(0)" ::: "memory");
            const unsigned og = xb_add(&bar[XB_TOP], 1u);
            const unsigned tg = og / nx;
            if (og + 1u == (tg + 1u) * nx) xb_add(&bar[XB_TOPGEN], 1u);
            else XB_SPIN(xb_ld(&bar[XB_TOPGEN]) == tg, bar);
            __builtin_amdgcn_fence(__ATOMIC_ACQUIRE, "agent");
            xb_add(&bar[XB_XGEN(b.x)], 1u);
            asm volatile("s_waitcnt vmcnt(0)" ::: "memory");
        } else {
            XB_SPIN(xb_ld(&bar[XB_XGEN(b.x)]) == gen, bar);
            __builtin_amdgcn_fence(__ATOMIC_ACQUIRE, "agent");
            asm volatile("s_waitcnt vmcnt(0)" ::: "memory");
        }
    }
    __syncthreads();
}
constexpr int BATCH = 2, SEQ = 4096, M = BATCH * SEQ, D = 2048, FF = 5632, DEPTH = 4, DIN = 5968, LDP = 6144, LDPP = 6208;
constexpr int NWAVES = 8;
constexpr int P_H = 0, P_GB = 512, P_GC = 1024, P_QB = 1536, P_KB = 2304, P_VB = 2432, P_QI = 2560, P_KI = 3584, P_QC = 3648, P_KC = 4416, P_VC = 5184, P_WI = 5952;
constexpr int Y_A = 0, Y_B = 512, Y_C = 1280;
constexpr float RMS_EPS = 1e-6f;
constexpr float SM_C = 0.08838834764831845f * 1.4426950408889634f;

constexpr size_t MiB = 1u << 20;
constexpr size_t WS_CTL = 0, CTL_ZERO_BYTES = 1 * MiB;
constexpr size_t WS_COSH = 1 * MiB, WS_SINH = 3 * MiB, WS_COSI = 5 * MiB, WS_SINI = 6 * MiB, WS_LSE = 7 * MiB;
constexpr size_t WS_XN = 8 * MiB, WS_YMIX = 40 * MiB, WS_H = 72 * MiB, WS_PROJ = 160 * MiB, WS_SCORES = 258 * MiB, WS_W = 386 * MiB;
constexpr size_t WL_GU1 = 0, WL_D1 = 44 * MiB, WL_IN = 66 * MiB, WL_OUT = 90 * MiB, WL_GU2 = 98 * MiB, WL_D2 = 142 * MiB, WL_STRIDE = 164 * MiB;
constexpr size_t WS_END = WS_W + DEPTH * WL_STRIDE;
static_assert((size_t)M * FF * 2 <= WS_PROJ - WS_H && (size_t)M * LDPP * 2 <= WS_SCORES - WS_PROJ && (size_t)M * SEQ * 4 <= WS_W - WS_SCORES, "ws map");
static_assert((size_t)2 * FF * D * 2 <= WL_D1 && (size_t)D * FF * 2 <= WL_IN - WL_D1 && (size_t)LDP * D * 2 <= WL_OUT - WL_IN && (size_t)D * D * 2 <= WL_GU2 - WL_OUT, "weight map");
constexpr int CW_BAR = 4096;

constexpr int RING_BYTES = 131072, MISC_OFF = RING_BYTES + 320, LDS_BYTES = 147456;

typedef unsigned short bf16;
typedef unsigned v4u __attribute__((ext_vector_type(4)));
typedef unsigned v2u __attribute__((ext_vector_type(2)));
typedef float f32x4 __attribute__((ext_vector_type(4)));
typedef float f32x16 __attribute__((ext_vector_type(16)));
typedef short bf16x8 __attribute__((ext_vector_type(8)));
typedef short s16x4 __attribute__((ext_vector_type(4)));

__device__ __forceinline__ unsigned f2bf(float f) { unsigned u = __builtin_bit_cast(unsigned, f); return (u + 0x7fffu + ((u >> 16) & 1u)) >> 16; }
__device__ __forceinline__ unsigned pk2(float lo, float hi) { return f2bf(lo) | (f2bf(hi) << 16); }
__device__ __forceinline__ float bf_lo(unsigned w) { return __builtin_bit_cast(float, w << 16); }
__device__ __forceinline__ float bf_hi(unsigned w) { return __builtin_bit_cast(float, w & 0xffff0000u); }
__device__ __forceinline__ float bf2f(bf16 b) { return __builtin_bit_cast(float, (unsigned)b << 16); }
__device__ __forceinline__ float wave_sum(float v) {
#pragma unroll
    for (int o = 1; o < 64; o <<= 1) v += __shfl_xor(v, o);
    return v;
}

__device__ const float INV_H[64] = {
1.000000000e+00f, 8.659643531e-01f, 7.498942018e-01f, 6.493816376e-01f, 5.623413324e-01f, 4.869675338e-01f, 4.216965139e-01f, 3.651741147e-01f, 3.162277639e-01f, 2.738419771e-01f, 2.371373922e-01f, 2.053525001e-01f, 1.778279394e-01f, 1.539926529e-01f, 1.333521456e-01f, 1.154782027e-01f, 1.000000015e-01f, 8.659642935e-02f, 7.498941571e-02f, 6.493816525e-02f, 5.623412877e-02f, 4.869675264e-02f, 4.216964915e-02f, 3.651741147e-02f, 3.162277862e-02f, 2.738419734e-02f, 2.371373586e-02f, 2.053524926e-02f, 1.778279431e-02f, 1.539926510e-02f, 1.333521493e-02f, 1.154781971e-02f, 9.999999776e-03f, 8.659643121e-03f, 7.498942316e-03f, 6.493816618e-03f, 5.623413250e-03f, 4.869675264e-03f, 4.216964822e-03f, 3.651741426e-03f, 3.162277862e-03f, 2.738419687e-03f, 2.371373819e-03f, 2.053525066e-03f, 1.778279431e-03f, 1.539926627e-03f, 1.333521446e-03f, 1.154781901e-03f, 1.000000047e-03f, 8.659643354e-04f, 7.498941850e-04f, 6.493816618e-04f, 5.623413017e-04f, 4.869675031e-04f, 4.216965463e-04f, 3.651741135e-04f, 3.162277862e-04f, 2.738419571e-04f, 2.371373848e-04f, 2.053525241e-04f, 1.778279402e-04f, 1.539926452e-04f, 1.333521504e-04f, 1.154782076e-04f };

struct Frame {
    LAS unsigned char* lds;
    int tid, lane, wave, bid, G, gw, NGW;
    unsigned char* ws;
};

template <int MODE> __device__ __forceinline__ int rowmap(int n) {
    if (MODE == 1) return 256 * (n >> 7) + (n & 127);
    if (MODE == 2) return 256 * (n >> 7) + 128 + (n & 127);
    if (MODE == 3) return n < 3648 ? n : (n < 3664 ? P_WI + (n - 3648) : n - 16);
    return n;
}
template <int MODE> __device__ __forceinline__ void transpose_item(const float* W, int K, int N, bf16* WT, LAS float* scr, int item, int lane) {
    const int nblk = (N + 31) / 32, kb = item / nblk, nb = item % nblk, k0 = 64 * kb, n0 = 32 * nb;
    const int nn = n0 + (lane & 31); const bool nok = nn < N;
#pragma unroll 8
    for (int i = 0; i < 32; ++i) { const int kk = 2 * i + (lane >> 5); scr[kk * 33 + (lane & 31)] = nok ? W[(size_t)(k0 + kk) * N + nn] : 0.f; }
    asm volatile("s_waitcnt lgkmcnt(0)" ::: "memory");
    const int c = lane & 7;
#pragma unroll
    for (int j = 0; j < 4; ++j) { const int n = (lane >> 3) + 8 * j; const LAS float* s = scr + (8 * c) * 33 + n;
        v4u o; o.x = pk2(s[0 * 33], s[1 * 33]); o.y = pk2(s[2 * 33], s[3 * 33]); o.z = pk2(s[4 * 33], s[5 * 33]); o.w = pk2(s[6 * 33], s[7 * 33]);
        if (n0 + n < N) *(v4u*)(WT + (size_t)rowmap<MODE>(n0 + n) * K + k0 + 8 * c) = o; }
    asm volatile("s_waitcnt lgkmcnt(0)" ::: "memory");
}
__device__ __forceinline__ void sincos_d(double a, float& sn, float& cs) {
    const double k = __builtin_rint(a * 0.63661977236758134308);
    double r = __builtin_fma(-k, 1.57079632679489655800e+00, a); r = __builtin_fma(-k, 6.12323399573676603587e-17, r);
    const int q = (int)((long long)k & 3);
    const double r2 = r * r;
    double s = -1.0 / 39916800.0; s = s * r2 + 1.0 / 362880.0; s = s * r2 - 1.0 / 5040.0; s = s * r2 + 1.0 / 120.0; s = s * r2 - 1.0 / 6.0; s = s * r2 * r + r;
    double c = 1.0 / 479001600.0; c = c * r2 - 1.0 / 3628800.0; c = c * r2 + 1.0 / 40320.0; c = c * r2 - 1.0 / 720.0; c = c * r2 + 1.0 / 24.0; c = c * r2 - 0.5; c = c * r2 + 1.0;
    const double ss = (q & 1) ? c : s, cc = (q & 1) ? s : c;
    sn = (float)((q & 2) ? -ss : ss); cs = (float)(((q + 1) & 2) ? -cc : cc);
}
struct Args { const void* in[15]; float* out; unsigned char* ws; int ph_lo, ph_hi; };
#define IN_X ((const float*)args.in[0])
#define IN_POS ((const int*)args.in[1])
#define IN_N1 ((const float*)args.in[2])
#define IN_G1 ((const float*)args.in[3])
#define IN_U1 ((const float*)args.in[4])
#define IN_D1 ((const float*)args.in[5])
#define IN_NM ((const float*)args.in[6])
#define IN_WIN ((const float*)args.in[7])
#define IN_CW ((const float*)args.in[8])
#define IN_WOUT ((const float*)args.in[9])
#define IN_N2 ((const float*)args.in[10])
#define IN_G2 ((const float*)args.in[11])
#define IN_U2 ((const float*)args.in[12])
#define IN_D2 ((const float*)args.in[13])
#define IN_NF ((const float*)args.in[14])
__device__ __forceinline__ void prologue(Frame& F, const Args& args) {
    LAS float* scr = (LAS float*)(F.lds + F.wave * 16384);
    constexpr int I_G = (D / 64) * (FF / 32), I_D = (FF / 64) * (D / 32), I_IN = (D / 64) * ((DIN + 31) / 32), I_OUT = (D / 64) * (D / 32);
    constexpr int PER_LAYER = 4 * I_G + 2 * I_D + I_IN + I_OUT;
    for (int it = F.gw; it < DEPTH * PER_LAYER; it += F.NGW) {
        const int L = it / PER_LAYER; int r = it % PER_LAYER;
        unsigned char* wl = F.ws + WS_W + (size_t)L * WL_STRIDE;
        const size_t og = (size_t)L * D * FF, oin = (size_t)L * D * DIN, oout = (size_t)L * D * D;
        if (r < I_G) { transpose_item<1>(IN_G1 + og, D, FF, (bf16*)(wl + WL_GU1), scr, r, F.lane); continue; } r -= I_G;
        if (r < I_G) { transpose_item<2>(IN_U1 + og, D, FF, (bf16*)(wl + WL_GU1), scr, r, F.lane); continue; } r -= I_G;
        if (r < I_D) { transpose_item<0>(IN_D1 + og, FF, D, (bf16*)(wl + WL_D1), scr, r, F.lane); continue; } r -= I_D;
        if (r < I_G) { transpose_item<1>(IN_G2 + og, D, FF, (bf16*)(wl + WL_GU2), scr, r, F.lane); continue; } r -= I_G;
        if (r < I_G) { transpose_item<2>(IN_U2 + og, D, FF, (bf16*)(wl + WL_GU2), scr, r, F.lane); continue; } r -= I_G;
        if (r < I_D) { transpose_item<0>(IN_D2 + og, FF, D, (bf16*)(wl + WL_D2), scr, r, F.lane); continue; } r -= I_D;
        if (r < I_IN) { transpose_item<3>(IN_WIN + oin, D, DIN, (bf16*)(wl + WL_IN), scr, r, F.lane); continue; } r -= I_IN;
        transpose_item<0>(IN_WOUT + oout, D, D, (bf16*)(wl + WL_OUT), scr, r, F.lane);
    }
    for (int L = 0; L < DEPTH; ++L) { v4u* p = (v4u*)(F.ws + WS_W + (size_t)L * WL_STRIDE + WL_IN + (size_t)DIN * D * 2);
        for (int i = F.gw * 64 + F.lane; i < (LDP - DIN) * D * 2 / 16; i += F.NGW * 64) p[i] = (v4u){0u, 0u, 0u, 0u}; }
    float* cosh_ = (float*)(F.ws + WS_COSH); float* sinh_ = (float*)(F.ws + WS_SINH); float* cosi_ = (float*)(F.ws + WS_COSI); float* sini_ = (float*)(F.ws + WS_SINI);
    for (int m = F.gw; m < M; m += F.NGW) { const float p = (float)IN_POS[m];
        { const float a = p * INV_H[F.lane]; float s, c; sincos_d((double)a, s, c); cosh_[m * 64 + F.lane] = c; sinh_[m * 64 + F.lane] = s; }
        if (F.lane < 32) { const float a = p * INV_H[2 * F.lane]; float s, c; sincos_d((double)a, s, c); cosi_[m * 32 + F.lane] = c; sini_[m * 32 + F.lane] = s; } }
}

__device__ __forceinline__ void norm_phase(Frame& F, const float* x, const float* g, bf16* xn) {
    for (int m = F.gw; m < M; m += F.NGW) {
        const f32x4* xr = (const f32x4*)(x + (size_t)m * D) + F.lane; f32x4 v[8]; float s = 0.f;
#pragma unroll
        for (int j = 0; j < 8; ++j) { v[j] = xr[64 * j]; s += (v[j].x * v[j].x + v[j].y * v[j].y) + (v[j].z * v[j].z + v[j].w * v[j].w); }
        const float r = 1.0f / sqrtf(wave_sum(s) * (1.0f / D) + RMS_EPS);
        v2u* o = (v2u*)(xn + (size_t)m * D) + F.lane;
#pragma unroll
        for (int j = 0; j < 8; ++j) { const f32x4 gg = ((const f32x4*)g)[F.lane + 64 * j]; v2u w; w.x = pk2(v[j].x * r * gg.x, v[j].y * r * gg.y); w.y = pk2(v[j].z * r * gg.z, v[j].w * r * gg.w); o[64 * j] = w; }
    }
}
__device__ __forceinline__ void final_norm_phase(Frame& F, float* x, const float* g) {
    for (int m = F.gw; m < M; m += F.NGW) {
        f32x4* xr = (f32x4*)(x + (size_t)m * D) + F.lane; f32x4 v[8]; float s = 0.f;
#pragma unroll
        for (int j = 0; j < 8; ++j) { v[j] = xr[64 * j]; s += (v[j].x * v[j].x + v[j].y * v[j].y) + (v[j].z * v[j].z + v[j].w * v[j].w); }
        const float r = 1.0f / sqrtf(wave_sum(s) * (1.0f / D) + RMS_EPS);
#pragma unroll
        for (int j = 0; j < 8; ++j) { const f32x4 gg = ((const f32x4*)g)[F.lane + 64 * j]; xr[64 * j] = v[j] * r * gg; }
    }
}

__device__ __forceinline__ void unpack8(const v4u w, float (&f)[8]) { f[0] = bf_lo(w.x); f[1] = bf_hi(w.x); f[2] = bf_lo(w.y); f[3] = bf_hi(w.y); f[4] = bf_lo(w.z); f[5] = bf_hi(w.z); f[6] = bf_lo(w.w); f[7] = bf_hi(w.w); }
__device__ __forceinline__ v4u pack8(const float (&f)[8]) { v4u w; w.x = pk2(f[0], f[1]); w.y = pk2(f[2], f[3]); w.z = pk2(f[4], f[5]); w.w = pk2(f[6], f[7]); return w; }
__device__ __forceinline__ void rope8(bf16* p1, bf16* p2, const float (&c)[8], const float (&s)[8], float sc) {
    float a[8], b[8], o1[8], o2[8]; unpack8(*(const v4u*)p1, a); unpack8(*(const v4u*)p2, b);
#pragma unroll
    for (int j = 0; j < 8; ++j) { o1[j] = (a[j] * c[j] - b[j] * s[j]) * sc; o2[j] = (b[j] * c[j] + a[j] * s[j]) * sc; }
    *(v4u*)p1 = pack8(o1); *(v4u*)p2 = pack8(o2);
}
__device__ __forceinline__ void rope_conv_phase(Frame& F, bf16* proj, bf16* ymix, const float* convw  ) {
    const float* cosh_ = (const float*)(F.ws + WS_COSH); const float* sinh_ = (const float*)(F.ws + WS_SINH); const float* cosi_ = (const float*)(F.ws + WS_COSI); const float* sini_ = (const float*)(F.ws + WS_SINI);
    const int lane = F.lane;
    float cw0[8], cw1[8], cw2[8];
#pragma unroll
    for (int j = 0; j < 8; ++j) { cw0[j] = convw[8 * lane + j]; cw1[j] = convw[512 + 8 * lane + j]; cw2[j] = convw[1024 + 8 * lane + j]; }
    for (int m = F.gw; m < M; m += F.NGW) {
        bf16* row = proj + (size_t)m * LDPP;
        { const int d8 = 8 * (lane & 7), hs = lane >> 3; float c[8], s[8];
          { const f32x4 c0 = *(const f32x4*)(cosh_ + m * 64 + d8), c1 = *(const f32x4*)(cosh_ + m * 64 + d8 + 4), s0 = *(const f32x4*)(sinh_ + m * 64 + d8), s1 = *(const f32x4*)(sinh_ + m * 64 + d8 + 4);
#pragma unroll
            for (int j = 0; j < 4; ++j) { c[j] = c0[j]; c[4 + j] = c1[j]; s[j] = s0[j]; s[4 + j] = s1[j]; } }
#pragma unroll
          for (int ps = 0; ps < 3; ++ps) { const int hd = ps * 8 + hs;
              if (hd < 19) { const int base = hd < 6 ? P_QB + hd * 128 : (hd == 6 ? P_KB : (hd < 13 ? P_QC + (hd - 7) * 128 : P_KC + (hd - 13) * 128));
                  rope8(row + base + d8, row + base + 64 + d8, c, s, 1.0f); } } }
        { const int d8 = 8 * (lane & 3), hd = lane >> 2; float c[8], s[8];
          { const f32x4 c0 = *(const f32x4*)(cosi_ + m * 32 + d8), c1 = *(const f32x4*)(cosi_ + m * 32 + d8 + 4), s0 = *(const f32x4*)(sini_ + m * 32 + d8), s1 = *(const f32x4*)(sini_ + m * 32 + d8 + 4);
#pragma unroll
            for (int j = 0; j < 4; ++j) { c[j] = c0[j]; c[4 + j] = c1[j]; s[j] = s0[j]; s[4 + j] = s1[j]; } }
          rope8(row + P_QI + hd * 64 + d8, row + P_QI + hd * 64 + 32 + d8, c, s, 0.125f);
          if (lane < 4) rope8(row + P_KI + d8, row + P_KI + 32 + d8, c, s, 1.0f); }
        { const int t = m & (SEQ - 1), ch = 8 * lane; float h0[8], g0[8], h1[8], g1[8], h2[8], g2[8], gb[8], y[8];
          unpack8(*(const v4u*)(row + P_H + ch), h0); unpack8(*(const v4u*)(row + P_GC + ch), g0); unpack8(*(const v4u*)(row + P_GB + ch), gb);
          if (t >= 1) { unpack8(*(const v4u*)(row - LDPP + P_H + ch), h1); unpack8(*(const v4u*)(row - LDPP + P_GC + ch), g1); } else {
#pragma unroll
              for (int j = 0; j < 8; ++j) { h1[j] = 0.f; g1[j] = 0.f; } }
          if (t >= 2) { unpack8(*(const v4u*)(row - 2 * LDPP + P_H + ch), h2); unpack8(*(const v4u*)(row - 2 * LDPP + P_GC + ch), g2); } else {
#pragma unroll
              for (int j = 0; j < 8; ++j) { h2[j] = 0.f; g2[j] = 0.f; } }
#pragma unroll
          for (int j = 0; j < 8; ++j) y[j] = gb[j] * (cw0[j] * (g2[j] * h2[j]) + cw1[j] * (g1[j] * h1[j]) + cw2[j] * (g0[j] * h0[j]));
          *(v4u*)(ymix + (size_t)m * D + Y_A + ch) = pack8(y); }
    }
}

__device__ __forceinline__ int crow(int r, int hi) { return (r & 3) + 8 * (r >> 2) + 4 * hi; }
constexpr int VROW = 320;
constexpr int VTILE = 32 * VROW;
struct AttnSt { f32x16 o[4]; float m, l; };
__device__ __forceinline__ void attn_init(AttnSt& st) {
#pragma unroll
    for (int d = 0; d < 4; ++d)
#pragma unroll
        for (int r = 0; r < 16; ++r) st.o[d][r] = 0.f;
    st.m = -1e30f; st.l = 0.f;
}
__device__ __forceinline__ s16x4 vtr(const LAS unsigned char* p) { return __builtin_bit_cast(s16x4, __builtin_amdgcn_ds_read_tr16_b64_v4i16((LAS s16x4*)p)); }
__device__ __forceinline__ void attn_tile(AttnSt& st, const bf16x8 (&qf)[8], const bf16* kp, const bf16* vp, LAS unsigned char* vl, unsigned vmask, int lane) {
    const int r32 = lane & 31, hi = lane >> 5;
    bf16x8 kf[8], vv[4];
#pragma unroll
    for (int ks = 0; ks < 8; ++ks) kf[ks] = *(const bf16x8*)(kp + ks * 16);
#pragma unroll
    for (int i = 0; i < 4; ++i) vv[i] = *(const bf16x8*)(vp + i * 16);
    f32x16 s;
#pragma unroll
    for (int r = 0; r < 16; ++r) s[r] = 0.f;
#pragma unroll
    for (int ks = 0; ks < 8; ++ks) s = __builtin_amdgcn_mfma_f32_32x32x16_bf16(kf[ks], qf[ks], s, 0, 0, 0);
#pragma unroll
    for (int i = 0; i < 4; ++i) *(LAS bf16x8*)(vl + r32 * VROW + (hi + 2 * i) * 16) = vv[i];
    asm volatile("" ::: "memory");
#pragma unroll
    for (int i = 0; i < 4; ++i) vv[i] = *(const bf16x8*)(vp + (i + 4) * 16);
#pragma unroll
    for (int i = 0; i < 4; ++i) *(LAS bf16x8*)(vl + r32 * VROW + (hi + 2 * (i + 4)) * 16) = vv[i];
    __builtin_amdgcn_sched_barrier(0);
    float mx = -INFINITY;
#pragma unroll
    for (int r = 0; r < 16; ++r) { s[r] = ((vmask >> r) & 1u) ? s[r] : -INFINITY; mx = fmaxf(mx, s[r]); }
    mx = fmaxf(mx, __shfl_xor(mx, 32));
    const float mn = fmaxf(st.m, mx), alpha = __builtin_amdgcn_exp2f((st.m - mn) * SM_C), mc = -mn * SM_C;
    st.m = mn;
    float ps = 0.f;
#pragma unroll
    for (int r = 0; r < 16; ++r) { s[r] = __builtin_amdgcn_exp2f(fmaf(s[r], SM_C, mc)); ps += s[r]; }
    st.l = st.l * alpha + ps;
#pragma unroll
    for (int d = 0; d < 4; ++d) st.o[d] = st.o[d] * alpha;
    bf16x8 pf[2];
#pragma unroll
    for (int sx = 0; sx < 2; ++sx) { v4u w; w.x = pk2(s[8 * sx + 0], s[8 * sx + 1]); w.y = pk2(s[8 * sx + 2], s[8 * sx + 3]); w.z = pk2(s[8 * sx + 4], s[8 * sx + 5]); w.w = pk2(s[8 * sx + 6], s[8 * sx + 7]); pf[sx] = __builtin_bit_cast(bf16x8, w); }
    __builtin_amdgcn_sched_barrier(0);
    const int g4 = lane >> 4, qq = (lane >> 2) & 3, pp = lane & 3;
    const LAS unsigned char* vb = vl + (4 * (g4 >> 1) + qq) * VROW + (16 * (g4 & 1) + 4 * pp) * 2;
#pragma unroll
    for (int d = 0; d < 4; ++d)
#pragma unroll
        for (int sx = 0; sx < 2; ++sx) { const s16x4 lo = vtr(vb + (16 * sx) * VROW + 64 * d), h8 = vtr(vb + (16 * sx + 8) * VROW + 64 * d);
            const bf16x8 a = (bf16x8){lo[0], lo[1], lo[2], lo[3], h8[0], h8[1], h8[2], h8[3]};
            st.o[d] = __builtin_amdgcn_mfma_f32_32x32x16_bf16(a, pf[sx], st.o[d], 0, 0, 0); if (sx == 1) __builtin_amdgcn_sched_barrier(0); }
}

__device__ __forceinline__ void indexer_unit(Frame& F, const bf16* proj, float* scores, int b, int tt, int kc) {
    const int lane = F.lane, r32 = lane & 31, hi = lane >> 5;
    const int t0 = tt * 64 + F.wave * 8;
    bf16x8 qa[4][4]; float wv[4][16];
    { const int tsel = (r32 >> 2) & 1, head = 4 * (r32 >> 3) + (r32 & 3);
#pragma unroll
      for (int a = 0; a < 4; ++a) { const bf16* qp = proj + (size_t)(b * SEQ + t0 + 2 * a + tsel) * LDPP + P_QI + head * 64 + hi * 8;
#pragma unroll
          for (int ks = 0; ks < 4; ++ks) qa[a][ks] = *(const bf16x8*)(qp + ks * 16);
          const v4u* wp = (const v4u*)(proj + (size_t)(b * SEQ + t0 + 2 * a + hi) * LDPP + P_WI); const v4u w0 = wp[0], w1 = wp[1];
          const unsigned ww[8] = {w0.x, w0.y, w0.z, w0.w, w1.x, w1.y, w1.z, w1.w};
#pragma unroll
          for (int j = 0; j < 8; ++j) { wv[a][2 * j] = 0.25f * bf_lo(ww[j]); wv[a][2 * j + 1] = 0.25f * bf_hi(ww[j]); } } }
    for (int kt = 0; kt < 8; ++kt) {
        const int k0 = kc * 256 + kt * 32;
        const bf16* kp = proj + (size_t)(b * SEQ + k0 + r32) * LDPP + P_KI + hi * 8;
        bf16x8 kf[4];
#pragma unroll
        for (int ks = 0; ks < 4; ++ks) kf[ks] = *(const bf16x8*)(kp + ks * 16);
#pragma unroll
        for (int a = 0; a < 4; ++a) { f32x16 acc;
#pragma unroll
            for (int r = 0; r < 16; ++r) acc[r] = 0.f;
#pragma unroll
            for (int ks = 0; ks < 4; ++ks) acc = __builtin_amdgcn_mfma_f32_32x32x16_bf16(qa[a][ks], kf[ks], acc, 0, 0, 0);
            float sc = 0.f;
#pragma unroll
            for (int r = 0; r < 16; ++r) sc = fmaf(wv[a][r], fmaxf(acc[r], 0.f), sc);
            scores[(size_t)(b * SEQ + t0 + 2 * a + hi) * SEQ + k0 + r32] = sc; }
    }
}
__device__ __forceinline__ void dilated_unit(Frame& F, const bf16* proj, bf16* ymix, float* lse, int wu) {
    const int lane = F.lane, r32 = lane & 31, hi = lane >> 5;
    const int b = wu / 768; int rem = wu % 768; const int g = rem >> 8; rem &= 255; const int hh = rem >> 7, ti = rem & 127;
    const int sh = 2 * g, dl = 1 << sh, tpc = 128 >> sh;
    const int r = ti / tpc, i0 = (ti % tpc) * 32, hd = g * 2 + hh;
    LAS unsigned char* vl = F.lds + F.wave * VTILE;
    const int tq = r + dl * (i0 + r32);
    bf16x8 qf[8];
    { const bf16* qp = proj + (size_t)(b * SEQ + tq) * LDPP + P_QC + hd * 128 + hi * 8;
#pragma unroll
      for (int ks = 0; ks < 8; ++ks) qf[ks] = *(const bf16x8*)(qp + ks * 16); }
    AttnSt st; attn_init(st);
    for (int kt = 0; kt < 5; ++kt) {
        const int ib = i0 - 128 + 32 * kt;
        if (ib + 31 < 0) continue;
        const int ik = ib + r32, ikc = ik < 0 ? 0 : ik;
        const bf16* rowp = proj + (size_t)(b * SEQ + r + dl * ikc) * LDPP + hd * 128 + hi * 8;
        unsigned vmask = 0u; const int iq = i0 + r32;
#pragma unroll
        for (int rr = 0; rr < 16; ++rr) { const int ikey = ib + crow(rr, hi); vmask |= (ikey >= 0 && ikey <= iq && ikey >= iq - 128) ? (1u << rr) : 0u; }
        attn_tile(st, qf, rowp + P_KC, rowp + P_VC, vl, vmask, lane);
    }
    const float lt = st.l + __shfl_xor(st.l, 32), inv = 1.0f / lt;
    bf16* op = ymix + (size_t)(b * SEQ + tq) * D + Y_C + hd * 128;
#pragma unroll
    for (int d = 0; d < 4; ++d)
#pragma unroll
        for (int r4 = 0; r4 < 4; ++r4) { v2u w; w.x = pk2(st.o[d][4 * r4] * inv, st.o[d][4 * r4 + 1] * inv); w.y = pk2(st.o[d][4 * r4 + 2] * inv, st.o[d][4 * r4 + 3] * inv);
            *(v2u*)(op + 32 * d + 8 * r4 + 4 * hi) = w; }
    if (hi == 0) lse[(size_t)(b * SEQ + tq) * 6 + hd] = st.m * SM_C + __builtin_amdgcn_logf(lt);
}
constexpr int N_IDX_UNITS = 2 * 544, N_DIL_WU = 2 * 3 * 2 * 128, N_P6_UNITS = N_IDX_UNITS + N_DIL_WU / NWAVES;
__device__ __forceinline__ void p6_phase(Frame& F, const bf16* proj, bf16* ymix, float* scores, float* lse) {
    for (int u = F.bid; u < N_P6_UNITS; u += F.G) {
        if (u < N_IDX_UNITS) { const int b = u / 544; int r = u % 544; int q = 0; while (r >= 4 * (q + 1)) { r -= 4 * (q + 1); ++q; }
            const int tt = 4 * q + r / (q + 1), kc = r % (q + 1);
            indexer_unit(F, proj, scores, b, tt, kc); }
        else dilated_unit(F, proj, ymix, lse, (u - N_IDX_UNITS) * NWAVES + F.wave);
    }
}

constexpr int VROW2 = 288;
__device__ __forceinline__ void dsa_attn(Frame& F, const bf16* proj, bf16* ymix, int m, int b, int nsel, LAS int* list, LAS unsigned char* vl) {
    const int lane = F.lane, c16 = lane & 15, g = lane >> 4, r32 = lane & 31, hi = lane >> 5;
    bf16x8 qf[4];
    { const bf16* qp = proj + (size_t)m * LDPP + P_QB + (c16 < 6 ? c16 : 0) * 128 + 8 * g;
#pragma unroll
      for (int ks = 0; ks < 4; ++ks) { qf[ks] = *(const bf16x8*)(qp + 32 * ks); if (c16 >= 6) qf[ks] = (bf16x8){0, 0, 0, 0, 0, 0, 0, 0}; } }
    f32x4 o[8];
#pragma unroll
    for (int d = 0; d < 8; ++d) o[d] = (f32x4){0.f, 0.f, 0.f, 0.f};
    float mrun = -1e30f, lrun = 0.f;
    const int ntile = (nsel + 31) >> 5;
    const bf16* kvb = proj + (size_t)(b * SEQ) * LDPP;
    bf16x8 kf[8], kn[8], vv[8];
    { const int s0 = c16, s1 = 16 + c16; const int k0 = s0 < nsel ? list[s0] : 0, k1 = s1 < nsel ? list[s1] : 0;
      const bf16* p0 = kvb + (size_t)k0 * LDPP + P_KB + 8 * g; const bf16* p1 = kvb + (size_t)k1 * LDPP + P_KB + 8 * g;
#pragma unroll
      for (int ks = 0; ks < 4; ++ks) { kf[ks] = *(const bf16x8*)(p0 + 32 * ks); kf[4 + ks] = *(const bf16x8*)(p1 + 32 * ks); }
      const bf16* vp = kvb + (size_t)((lane & 16) ? k1 : k0) * LDPP + P_VB + 8 * hi;
#pragma unroll
      for (int i = 0; i < 8; ++i) vv[i] = *(const bf16x8*)(vp + 16 * i); }
    const LAS unsigned char* vb = vl + (4 * g + (c16 >> 2)) * VROW2 + (4 * (c16 & 3)) * 2;
    for (int kt = 0; kt < ntile; ++kt) {
        const int ktn = kt + 1 < ntile ? kt + 1 : kt;
        const int s0 = ktn * 32 + c16, s1 = s0 + 16; const int k0 = s0 < nsel ? list[s0] : 0, k1 = s1 < nsel ? list[s1] : 0;
        { const bf16* p0 = kvb + (size_t)k0 * LDPP + P_KB + 8 * g; const bf16* p1 = kvb + (size_t)k1 * LDPP + P_KB + 8 * g;
#pragma unroll
          for (int ks = 0; ks < 4; ++ks) { kn[ks] = *(const bf16x8*)(p0 + 32 * ks); kn[4 + ks] = *(const bf16x8*)(p1 + 32 * ks); } }
        __builtin_amdgcn_sched_barrier(0);
        f32x4 sa = (f32x4){0.f, 0.f, 0.f, 0.f}, sb = (f32x4){0.f, 0.f, 0.f, 0.f};
#pragma unroll
        for (int ks = 0; ks < 4; ++ks) { sa = __builtin_amdgcn_mfma_f32_16x16x32_bf16(kf[ks], qf[ks], sa, 0, 0, 0); sb = __builtin_amdgcn_mfma_f32_16x16x32_bf16(kf[4 + ks], qf[ks], sb, 0, 0, 0); }
#pragma unroll
        for (int i = 0; i < 8; ++i) *(LAS bf16x8*)(vl + r32 * VROW2 + (hi + 2 * i) * 16) = vv[i];
        { const bf16* vp = kvb + (size_t)((lane & 16) ? k1 : k0) * LDPP + P_VB + 8 * hi;
#pragma unroll
          for (int i = 0; i < 8; ++i) vv[i] = *(const bf16x8*)(vp + 16 * i); }
        __builtin_amdgcn_sched_barrier(0);
        const int kb = kt * 32 + 4 * g; float mx = -INFINITY;
#pragma unroll
        for (int j = 0; j < 4; ++j) { sa[j] = (kb + j < nsel) ? sa[j] : -INFINITY; sb[j] = (kb + 16 + j < nsel) ? sb[j] : -INFINITY; mx = fmaxf(mx, fmaxf(sa[j], sb[j])); }
        mx = fmaxf(mx, __shfl_xor(mx, 16)); mx = fmaxf(mx, __shfl_xor(mx, 32));
        const float mn = fmaxf(mrun, mx), alpha = __builtin_amdgcn_exp2f((mrun - mn) * SM_C), mc = -mn * SM_C; mrun = mn;
        float ps = 0.f;
#pragma unroll
        for (int j = 0; j < 4; ++j) { sa[j] = __builtin_amdgcn_exp2f(fmaf(sa[j], SM_C, mc)); sb[j] = __builtin_amdgcn_exp2f(fmaf(sb[j], SM_C, mc)); ps += sa[j] + sb[j]; }
        lrun = lrun * alpha + ps;
#pragma unroll
        for (int d = 0; d < 8; ++d) o[d] = o[d] * alpha;
        v4u pw; pw.x = pk2(sa[0], sa[1]); pw.y = pk2(sa[2], sa[3]); pw.z = pk2(sb[0], sb[1]); pw.w = pk2(sb[2], sb[3]);
        const bf16x8 pf = __builtin_bit_cast(bf16x8, pw);
#pragma unroll
        for (int d = 0; d < 8; ++d) { const s16x4 lo = vtr(vb + 32 * d), h8 = vtr(vb + 16 * VROW2 + 32 * d);
            const bf16x8 a = (bf16x8){lo[0], lo[1], lo[2], lo[3], h8[0], h8[1], h8[2], h8[3]};
            o[d] = __builtin_amdgcn_mfma_f32_16x16x32_bf16(a, pf, o[d], 0, 0, 0); }
        __builtin_amdgcn_sched_barrier(0);
#pragma unroll
        for (int i = 0; i < 8; ++i) kf[i] = kn[i];
    }
    float lt = lrun + __shfl_xor(lrun, 16); lt += __shfl_xor(lt, 32);
    const float inv = 1.0f / lt;
    if (c16 < 6) { bf16* op = ymix + (size_t)m * D + Y_B + c16 * 128 + 4 * g;
#pragma unroll
        for (int d = 0; d < 8; ++d) { v2u w; w.x = pk2(o[d][0] * inv, o[d][1] * inv); w.y = pk2(o[d][2] * inv, o[d][3] * inv); *(v2u*)(op + 16 * d) = w; } }
}

__device__ __forceinline__ unsigned f2ord(float f) { const unsigned b = __builtin_bit_cast(unsigned, f); return b ^ ((unsigned)((int)b >> 31) | 0x80000000u); }
__device__ __forceinline__ void p7_phase(Frame& F, const bf16* proj, bf16* ymix, const float* scores, const float* lse, const int pmode  ) {
    const int lane = F.lane, r32 = lane & 31, hi = lane >> 5;
    LAS unsigned char* vl = F.lds + F.wave * VTILE;
    LAS int* list = (LAS int*)(F.lds + NWAVES * VTILE + F.wave * 1024);
    const int per_b = F.NGW >> 1;
    for (int it = (F.bid >> 1) * NWAVES + F.wave; it < SEQ; it += per_b) {
        const int b = F.bid & 1, t = it, m = b * SEQ + t;
        { float ls[6];
#pragma unroll
          for (int i = 0; i < 6; ++i) ls[i] = lse[(size_t)m * 6 + i];
          unsigned* yc = (unsigned*)(ymix + (size_t)m * D + Y_C);
#pragma unroll
          for (int hh = 0; hh < 2; ++hh) { const float mx = fmaxf(ls[hh], fmaxf(ls[2 + hh], ls[4 + hh]));
              const float e0 = __builtin_amdgcn_exp2f(ls[hh] - mx), e1 = __builtin_amdgcn_exp2f(ls[2 + hh] - mx), e2 = __builtin_amdgcn_exp2f(ls[4 + hh] - mx), rs = 1.0f / (e0 + e1 + e2);
              const float al[3] = {e0 * rs, e1 * rs, e2 * rs};
#pragma unroll
              for (int g = 0; g < 3; ++g) { const int idx = (g * 2 + hh) * 64 + lane; const unsigned w = yc[idx]; yc[idx] = pk2(bf_lo(w) * al[g], bf_hi(w) * al[g]); } } }
        const float* srow = scores + (size_t)m * SEQ;
        unsigned u[64];
        { const float* sp = srow + lane; float f[64];
#pragma unroll
          for (int j = 0; j < 32; ++j) f[j] = sp[j * 64];
          if (t >= 2048) {
#pragma unroll
              for (int j = 32; j < 64; ++j) f[j] = sp[j * 64];
          } else {
#pragma unroll
              for (int j = 32; j < 64; ++j) f[j] = 0.f;
          }
#pragma unroll
          for (int j = 0; j < 64; ++j) u[j] = (lane <= t - j * 64) ? f2ord(f[j]) : 0u; }
        unsigned T = 0u; int need = 0;
        if (t + 1 > 256 && !(pmode & 2)) {
            bool exact = false;
            for (int bit = 31; bit >= 0; --bit) {
                const unsigned cand = T | (1u << bit); int cnt = 0;
#pragma unroll
                for (int j = 0; j < 64; ++j) { cnt += __popcll(__ballot(u[j] >= cand)); if ((j & 15) == 15) __builtin_amdgcn_sched_barrier(0); }
                if (cnt >= 256) { T = cand; if (cnt == 256) { exact = true; break; } }
            }
            if (exact) need = 0x7fffffff;
            else { int ngt = 0;
#pragma unroll
                for (int j = 0; j < 64; ++j) ngt += __popcll(__ballot(u[j] > T));
                need = 256 - ngt; }
        }
        int nsel = 0, eqtaken = 0;
#pragma unroll
        for (int j = 0; j < 64; ++j) {
            const bool gt = u[j] > T, eq = (u[j] == T) && (T != 0u);
            const unsigned long long meq = __ballot(eq);
            const int eqrank = eqtaken + __popcll(meq & ((1ull << lane) - 1ull));
            const bool take = gt || (eq && eqrank < need);
            const unsigned long long mt = __ballot(take);
            if (take) list[nsel + __popcll(mt & ((1ull << lane) - 1ull))] = j * 64 + lane;
            nsel += __popcll(mt); eqtaken += __popcll(meq);
            if ((j & 3) == 3) __builtin_amdgcn_sched_barrier(0);
        }
        if (pmode & 2) nsel = nsel > 256 ? 256 : nsel;
        if (!(pmode & 1)) dsa_attn(F, proj, ymix, m, b, nsel, list, vl);
    }
}

constexpr int PH_PRO = 0, PH_PER_LAYER = 12, PH_FINAL = 1 + DEPTH * PH_PER_LAYER, N_PHASES = PH_FINAL + 1;
__global__ void __launch_bounds__(NWAVES * 64, 2) fwd_kernel(Args args) {
    extern __shared__ __attribute__((aligned(16))) unsigned char lds[];
    Frame F;
    F.lds = (LAS unsigned char*)lds; F.tid = threadIdx.x; F.lane = F.tid & 63; F.wave = __builtin_amdgcn_readfirstlane(F.tid >> 6); F.bid = blockIdx.x;
    const int wave0 = F.wave;
    F.G = gridDim.x; F.gw = blockIdx.x * NWAVES + F.wave; F.NGW = F.G * NWAVES; F.ws = args.ws;
    volatile LAS unsigned* MISC = (volatile LAS unsigned*)(F.lds + MISC_OFF);
    for (int i = F.tid; i < (LDS_BYTES - RING_BYTES) / 4; i += NWAVES * 64) ((LAS unsigned*)(F.lds + RING_BYTES))[i] = 0u;
    __syncthreads();
    const int lo = args.ph_lo, hi = args.ph_hi;
    XcdBarrier bar; bar.bar = (unsigned*)(args.ws + WS_CTL) + CW_BAR; bar.x = 0; bar.st = nullptr;
    if (hi - lo > 1) bar = xcd_barrier_post((unsigned*)(args.ws + WS_CTL) + CW_BAR, MISC + 8);
#define IN(k) (lo <= (k) && (k) < hi)
#ifndef PHMASK
#define PHMASK 0xFFFF
#endif
#define PHM(b) ((PHMASK >> (b)) & 1)
#define RELANE() do { int w_ = wave0, b_ = blockIdx.x; asm volatile("" : "+s"(w_), "+s"(b_)); int l_; asm volatile("v_mbcnt_lo_u32_b32 %0, -1, 0\n\tv_mbcnt_hi_u32_b32 %0, -1, %0" : "=v"(l_)); F.wave = w_; F.bid = b_; F.lane = l_; F.tid = w_ * 64 + l_; F.gw = b_ * NWAVES + w_; } while (0)
#define SEAM(k) do { if (IN(k) && IN((k) + 1)) xcd_barrier(bar); } while (0)
    float* X = args.out;
    bf16* XN = (bf16*)(args.ws + WS_XN); bf16* YMIX = (bf16*)(args.ws + WS_YMIX); bf16* HB = (bf16*)(args.ws + WS_H); bf16* PROJ = (bf16*)(args.ws + WS_PROJ);
    float* SCORES = (float*)(args.ws + WS_SCORES); float* LSE = (float*)(args.ws + WS_LSE);

#ifndef PROBEMASK
#define PROBEMASK 0
#endif
#ifndef PROBE_NX
#define PROBE_NX 4
#endif
#define XPM(b) ((PROBEMASK >> (b)) & 1)
#ifndef PROBE_P7MODE
#define PROBE_P7MODE 0
#endif
#define PHASE(k, b, ...) do { if (PHM(b) && (extra ? XPM(b) : IN(k))) { RELANE(); __VA_ARGS__ } if (extra ? XPM(b) : (IN(k) && IN((k) + 1))) xcd_barrier(bar); } while (0)
    { for (int r_ = 0; r_ < 1 + XPM(0) * PROBE_NX; ++r_) { if (r_) xcd_barrier(bar); if (PHM(0) && IN(PH_PRO)) { RELANE(); prologue(F, args); } } SEAM(PH_PRO); }

    for (int Lx = 0; Lx < DEPTH + (PROBEMASK ? PROBE_NX : 0); ++Lx) {
        const bool extra = Lx >= DEPTH; const int L = extra ? DEPTH - 1 : Lx;
        const int pb = 1 + L * PH_PER_LAYER;
        if (!extra && (hi <= pb || lo >= pb + PH_PER_LAYER)) continue;
        if (extra && !IN(PH_FINAL)) continue;
        const float rs = extra ? 0.f : 1.f;
        unsigned char* wl = args.ws + WS_W + (size_t)L * WL_STRIDE;
        PHASE(pb + 0, 1, norm_phase(F, L == 0 ? IN_X : X, IN_N1 + L * D, XN););
        PHASE(pb + 1, 2, pg8::Gemm g{XN, (const bf16*)(wl + WL_GU1), M, 2 * FF, D}; pg8::StaticOrder S; S.init(M, 2 * FF, F.G, F.bid); pg8::EpiSwiglu E{HB, FF};
            pg8::gemm_phase<pg8::EpiSwiglu, pg8::StaticOrder, true, true>(F.lds, g, S, E, F.tid););
        PHASE(pb + 2, 3, pg8::Gemm g{HB, (const bf16*)(wl + WL_D1), M, D, FF}; pg8::StaticOrder S; S.init(M, D, F.G, F.bid); pg8::EpiResid E{L == 0 ? IN_X : X, X, D, 0.5f * rs};
            pg8::gemm_phase<pg8::EpiResid, pg8::StaticOrder, true, true>(F.lds, g, S, E, F.tid););
        PHASE(pb + 3, 1, norm_phase(F, X, IN_NM + L * D, XN););
        PHASE(pb + 4, 4, pg8::Gemm g{XN, (const bf16*)(wl + WL_IN), M, LDP, D}; pg8::StaticOrder S; S.init(M, LDP, F.G, F.bid); pg8::EpiStoreBf16 E{PROJ, LDPP};
            pg8::gemm_phase<pg8::EpiStoreBf16, pg8::StaticOrder, true, true>(F.lds, g, S, E, F.tid););
        PHASE(pb + 5, 5, rope_conv_phase(F, PROJ, YMIX, IN_CW + L * 3 * 512););
        PHASE(pb + 6, 6, p6_phase(F, PROJ, YMIX, SCORES, LSE););
        PHASE(pb + 7, 7, p7_phase(F, PROJ, YMIX, SCORES, LSE, extra ? PROBE_P7MODE : 0););
        PHASE(pb + 8, 8, pg8::Gemm g{YMIX, (const bf16*)(wl + WL_OUT), M, D, D}; pg8::StaticOrder S; S.init(M, D, F.G, F.bid); pg8::EpiResid E{X, X, D, rs};
            pg8::gemm_phase<pg8::EpiResid, pg8::StaticOrder, true, true>(F.lds, g, S, E, F.tid););
        PHASE(pb + 9, 1, norm_phase(F, X, IN_N2 + L * D, XN););
        PHASE(pb + 10, 2, pg8::Gemm g{XN, (const bf16*)(wl + WL_GU2), M, 2 * FF, D}; pg8::StaticOrder S; S.init(M, 2 * FF, F.G, F.bid); pg8::EpiSwiglu E{HB, FF};
            pg8::gemm_phase<pg8::EpiSwiglu, pg8::StaticOrder, true, true>(F.lds, g, S, E, F.tid););
        PHASE(pb + 11, 3, pg8::Gemm g{HB, (const bf16*)(wl + WL_D2), M, D, FF}; pg8::StaticOrder S; S.init(M, D, F.G, F.bid); pg8::EpiResid E{X, X, D, 0.5f * rs};
            pg8::gemm_phase<pg8::EpiResid, pg8::StaticOrder, true, true>(F.lds, g, S, E, F.tid););
    }
    if (PHM(9) && IN(PH_FINAL)) { RELANE(); final_norm_phase(F, X, IN_NF); }
#undef IN
#undef SEAM
}

#ifndef MK_PER_PHASE
#define MK_PER_PHASE 0
#endif
extern "C" void kernel_launch(void* const* d_in, const int* in_sizes, int n_in, void* d_out, int out_size, void* d_ws, size_t ws_size, hipStream_t stream) {
    static int grid = 0;
    if (grid == 0) {
        if (n_in != 15 || out_size != M * D || ws_size < WS_END) { fprintf(stderr, "kernel_launch: unexpected shapes (n_in %d, out %d, ws %zu < %zu); nothing launched\n", n_in, out_size, ws_size, (size_t)WS_END); grid = -1; return; }
        int dev = 0, cus = 0, per_cu = 0;
        if (hipGetDevice(&dev) != hipSuccess || hipDeviceGetAttribute(&cus, hipDeviceAttributeMultiprocessorCount, dev) != hipSuccess) { grid = -1; return; }
        if (hipFuncSetAttribute((const void*)fwd_kernel, hipFuncAttributeMaxDynamicSharedMemorySize, LDS_BYTES) != hipSuccess) { fprintf(stderr, "kernel_launch: hipFuncSetAttribute failed\n"); grid = -1; return; }
        if (hipOccupancyMaxActiveBlocksPerMultiprocessor(&per_cu, (const void*)fwd_kernel, NWAVES * 64, LDS_BYTES) != hipSuccess || per_cu < 1) fprintf(stderr, "kernel_launch: occupancy query says %d\n", per_cu);
        (void)hipGetLastError();
        grid = cus;
    }
    if (grid < 0) return;
    if (hipMemsetAsync((char*)d_ws + WS_CTL, 0, CTL_ZERO_BYTES, stream) != hipSuccess) return;
    Args a{};
    for (int i = 0; i < 15; ++i) a.in[i] = d_in[i];
    a.out = (float*)d_out; a.ws = (unsigned char*)d_ws;
#if MK_PER_PHASE
    for (int p = 0; p < N_PHASES; ++p) { a.ph_lo = p; a.ph_hi = p + 1; hipLaunchKernelGGL(fwd_kernel, dim3(grid), dim3(NWAVES * 64), LDS_BYTES, stream, a); }
#else
    a.ph_lo = 0; a.ph_hi = N_PHASES;
    hipLaunchKernelGGL(fwd_kernel, dim3(grid), dim3(NWAVES * 64), LDS_BYTES, stream, a);
#endif
}
```

```cpp
#include <hip/hip_runtime.h>
#include <cstdio>
#include <cstdint>
namespace pg8 {
#define PG8_LAS __attribute__((address_space(3)))
typedef unsigned short bf16_t;
typedef short bf16x8 __attribute__((ext_vector_type(8)));
typedef float f32x4 __attribute__((ext_vector_type(4)));
typedef unsigned u32x4 __attribute__((ext_vector_type(4)));
constexpr int BM = 256, BK = 64, HALF = 128, HTB = HALF * BK * 2  , STAGE_BYTES = 8 * HTB, NXCD = 8, WGM = 8;

__host__ __device__ __forceinline__ int lds_byte(int r, int c) { const int st = (r >> 4) * 2 + (c >> 5), rr = r & 15, cc = c & 31, ob = rr * 64 + cc * 2; return st * 1024 + (ob ^ (((ob >> 9) & 1) << 5)); }
__host__ __device__ __forceinline__ void stage_rc(int b, int& R, int& C) { const int st = b / 1024, sb = b % 1024, swz = sb ^ (((sb >> 9) & 1) << 5); R = (st >> 1) * 16 + swz / 64; C = (st & 1) * 32 + (swz % 64) / 2; }
__host__ __device__ __forceinline__ int perm32(int rho) { const int n = rho >> 4, i = rho & 15; return 8 * (i >> 2) + 4 * n + (i & 3); }

struct Unit { int pm, pn; };
struct Gemm { const bf16_t* A; const bf16_t* Bt; int M, N, K; };

struct StaticOrder {
    int nM, nN, nwg, G, c;
    __host__ __device__ void init(int M, int N, int G_, int c_) { nM = M / BM; nN = N / BM; nwg = nM * nN; G = G_; c = c_; }
    __host__ __device__ bool next(int i, Unit& u) const {
        const long L = (long)i * G + c; if (L >= nwg) return false;
        int wgid = (int)L; { const int q = nwg / NXCD, r = nwg % NXCD, xcd = wgid % NXCD, off = wgid / NXCD; wgid = (xcd < r ? xcd * (q + 1) : r * (q + 1) + (xcd - r) * q) + off; }
        const int nig = WGM * nN, gid = wgid / nig, fm = gid * WGM, gsz = (nM - fm) < WGM ? (nM - fm) : WGM;
        u.pm = fm + ((wgid % nig) % gsz); u.pn = (wgid % nig) / gsz; return true;
    }
    __device__ __forceinline__ void a_ready(const Unit&) const {}
    __device__ __forceinline__ void done(const Unit&) const {}
};

__device__ __forceinline__ unsigned cvt_pk_bf16(float lo, float hi) { unsigned r; asm volatile("v_cvt_pk_bf16_f32 %0, %1, %2" : "=v"(r) : "v"(lo), "v"(hi)); return r; }
typedef float f32x2 __attribute__((ext_vector_type(2)));
__device__ __forceinline__ void swap16(float& a, float& b) { asm volatile("s_nop 1\n\tv_permlane16_swap_b32 %0, %1" : "+v"(a), "+v"(b)); }
__device__ __forceinline__ void swap32(float& a, float& b) { asm volatile("s_nop 1\n\tv_permlane32_swap_b32 %0, %1" : "+v"(a), "+v"(b)); }
__device__ __forceinline__ float xadd16(float v) { float a = v, b = v; swap16(a, b); return a + b; }
__device__ __forceinline__ float xadd32(float v) { float a = v, b = v; swap32(a, b); return a + b; }
constexpr float RMS_EPS_ = 1e-6f;
__device__ __forceinline__ void row_rsqrt(const float* rss, int row0, int fq, int ncols, float (&rr)[2][4]) {
    f32x4 pa[8], pb[8];
#pragma unroll
    for (int i = 0; i < 8; ++i) { const f32x4* p = (const f32x4*)(rss + (size_t)(row0 + (i >> 2) * HALF + (i & 3) * 16) * 32 + fq * 8); pa[i] = p[0]; pb[i] = p[1]; }
#pragma unroll
    for (int i = 0; i < 8; ++i) { const f32x4 a = pa[i], b = pb[i];
        float s = ((a[0] + a[1]) + (a[2] + a[3])) + ((b[0] + b[1]) + (b[2] + b[3])); s = xadd16(s); s = xadd32(s);
        rr[i >> 2][i & 3] = __builtin_amdgcn_rsqf(s * (1.0f / (float)ncols) + RMS_EPS_); }
}
struct EpiStoreBf16 {
    static constexpr bool PERM = true, AFTER_DRAIN = false;
    bf16_t* O; int ldc; const float* rss; int ncols;
    __device__ __forceinline__ void operator()(const f32x4 (&acc)[2][2][4][2], const Unit& u, int wr, int wc, int fr, int fq) const {
        const int row0 = u.pm * BM + wr * 64 + fr, col0 = u.pn * BM + wc * 32 + 8 * fq;
        float rr[2][4]; row_rsqrt(rss, row0, fq, ncols, rr);
#pragma unroll
        for (int ai = 0; ai < 2; ++ai)
#pragma unroll
            for (int m = 0; m < 4; ++m) { bf16_t* rowp = O + (size_t)(row0 + ai * HALF + m * 16) * ldc + col0; const float r = rr[ai][m];
#pragma unroll
                for (int bj = 0; bj < 2; ++bj) { const f32x4 v0 = acc[ai][bj][m][0] * r, v1 = acc[ai][bj][m][1] * r;
                    u32x4 w; w.x = cvt_pk_bf16(v0[0], v0[1]); w.y = cvt_pk_bf16(v0[2], v0[3]); w.z = cvt_pk_bf16(v1[0], v1[1]); w.w = cvt_pk_bf16(v1[2], v1[3]);
                    *(u32x4*)(rowp + bj * HALF) = w; } }
    }
};
struct EpiSwiglu {
    static constexpr bool PERM = true, AFTER_DRAIN = false;
    bf16_t* H; int ldh; const float* rss; int ncols;
    __device__ __forceinline__ static float silu_mul(float g, float u) { return g * u * __builtin_amdgcn_rcpf(1.0f + __builtin_amdgcn_exp2f(-1.4426950408889634f * g)); }
    __device__ __forceinline__ void operator()(const f32x4 (&acc)[2][2][4][2], const Unit& u, int wr, int wc, int fr, int fq) const {
        const int row0 = u.pm * BM + wr * 64 + fr, col0 = u.pn * HALF + wc * 32 + 8 * fq;
        float rr[2][4]; row_rsqrt(rss, row0, fq, ncols, rr);
#pragma unroll
        for (int ai = 0; ai < 2; ++ai)
#pragma unroll
            for (int m = 0; m < 4; ++m) { bf16_t* rowp = H + (size_t)(row0 + ai * HALF + m * 16) * ldh + col0; const float r = rr[ai][m];
                const f32x4 g0 = acc[ai][0][m][0] * r, g1 = acc[ai][0][m][1] * r, u0 = acc[ai][1][m][0] * r, u1 = acc[ai][1][m][1] * r;
                u32x4 w;
                w.x = cvt_pk_bf16(silu_mul(g0[0], u0[0]), silu_mul(g0[1], u0[1])); w.y = cvt_pk_bf16(silu_mul(g0[2], u0[2]), silu_mul(g0[3], u0[3]));
                w.z = cvt_pk_bf16(silu_mul(g1[0], u1[0]), silu_mul(g1[1], u1[1])); w.w = cvt_pk_bf16(silu_mul(g1[2], u1[2]), silu_mul(g1[3], u1[3]));
                *(u32x4*)rowp = w; }
    }
};
struct EpiResid {
    static constexpr bool PERM = true, AFTER_DRAIN = false;
    const float* src; float* dst; bf16_t* xb; float* rss; int ldc; float scale;
    __device__ __forceinline__ void operator()(const f32x4 (&acc)[2][2][4][2], const Unit& u, int wr, int wc, int fr, int fq) const {
        const int row0 = u.pm * BM + wr * 64 + fr, col0 = u.pn * BM + wc * 32 + 8 * fq;
#pragma unroll
        for (int ai = 0; ai < 2; ++ai)
#pragma unroll
            for (int mp = 0; mp < 2; ++mp) {
                f32x4 b[2][2][2]; float ss[2];
#pragma unroll
                for (int q = 0; q < 2; ++q) { const size_t off = (size_t)(row0 + ai * HALF + (2 * mp + q) * 16) * ldc + col0;
#pragma unroll
                    for (int bj = 0; bj < 2; ++bj) { b[q][bj][0] = *(const f32x4*)(src + off + bj * HALF); b[q][bj][1] = *(const f32x4*)(src + off + bj * HALF + 4); } }
#pragma unroll
                for (int q = 0; q < 2; ++q) { const int m = 2 * mp + q; const size_t off = (size_t)(row0 + ai * HALF + m * 16) * ldc + col0; float s = 0.f;
#pragma unroll
                    for (int bj = 0; bj < 2; ++bj) { const f32x4 v0 = b[q][bj][0] + acc[ai][bj][m][0] * scale, v1 = b[q][bj][1] + acc[ai][bj][m][1] * scale;
                        *(f32x4*)(dst + off + bj * HALF) = v0; *(f32x4*)(dst + off + bj * HALF + 4) = v1;
                        s += ((v0[0] * v0[0] + v0[1] * v0[1]) + (v0[2] * v0[2] + v0[3] * v0[3])) + ((v1[0] * v1[0] + v1[1] * v1[1]) + (v1[2] * v1[2] + v1[3] * v1[3]));
                        u32x4 w; w.x = cvt_pk_bf16(v0[0], v0[1]); w.y = cvt_pk_bf16(v0[2], v0[3]); w.z = cvt_pk_bf16(v1[0], v1[1]); w.w = cvt_pk_bf16(v1[2], v1[3]);
                        *(u32x4*)(xb + off + bj * HALF) = w; }
                    ss[q] = s; }
#pragma unroll
                for (int q = 0; q < 2; ++q) { float s = xadd16(ss[q]); s = xadd32(s);
                    if (fq == 0) rss[(size_t)(row0 + ai * HALF + (2 * mp + q) * 16) * 32 + u.pn * 4 + wc] = s; }
                asm volatile("" ::: "memory"); }
    }
};
template <class Epi, class Sched, bool ALIGN_EPI = false, bool SP2 = false>
__device__ __forceinline__ void gemm_phase(PG8_LAS unsigned char* lds, const Gemm g, const Sched& S, const Epi& E, const int tid_in  ) {
    const int tid = tid_in, wid = __builtin_amdgcn_readfirstlane(tid >> 6), lane = tid & 63, wr = wid >> 2, wc = wid & 3, fr = lane & 15, fq = lane >> 4;
    const int K = g.K, nt = K / BK;
    unsigned voffA[2], voffB[2];
#pragma unroll
    for (int i = 0; i < 2; ++i) { int R, C; stage_rc(tid * 16 + i * 8192, R, C); const int Rb = Epi::PERM ? ((R & ~31) + perm32(R & 31)) : R;
        voffA[i] = (unsigned)(R * K + C) * 2u; voffB[i] = (unsigned)(Rb * K + C) * 2u; }
    const size_t kstep = (size_t)(BK * 2);
    const size_t hstep = (size_t)HALF * K * 2;
    const size_t tstep = 2 * hstep;
    const unsigned ldsw = (unsigned)wid * 1024u;
    const int aoff = lds_byte(wr * 64 + fr, fq * 8), boff = lds_byte(wc * 32 + fr, fq * 8);
#define PG8_SA(b, h) (((b) * 2 + (h)) * HTB)
#define PG8_SB(b, h) ((4 + (b) * 2 + (h)) * HTB)
#define PG8_STAGE(bufoff, gbase, voff) do { _Pragma("unroll") for (int _i = 0; _i < 2; ++_i) \
        __builtin_amdgcn_global_load_lds((const unsigned*)((const char*)(gbase) + (voff)[_i]), (PG8_LAS unsigned*)(lds + (bufoff) + ldsw + _i * 8192), 16, 0, 0); } while (0)
#define PG8_LDA(dst, b, h) do { _Pragma("unroll") for (int m = 0; m < 4; ++m) _Pragma("unroll") for (int k = 0; k < 2; ++k) dst[m][k] = *(const PG8_LAS bf16x8*)(lds + PG8_SA(b, h) + aoff + m * 2048 + k * 1024); } while (0)
#define PG8_LDB(dst, b, h) do { _Pragma("unroll") for (int n = 0; n < 2; ++n) _Pragma("unroll") for (int k = 0; k < 2; ++k) dst[n][k] = *(const PG8_LAS bf16x8*)(lds + PG8_SB(b, h) + boff + n * 2048 + k * 1024); } while (0)
#define PG8_MMA(ai, bj, At, Bt) do { __builtin_amdgcn_s_setprio(1); _Pragma("unroll") for (int m = 0; m < 4; ++m) _Pragma("unroll") for (int n = 0; n < 2; ++n) _Pragma("unroll") for (int k = 0; k < 2; ++k) \
        acc[ai][bj][m][n] = __builtin_amdgcn_mfma_f32_16x16x32_bf16(Bt[n][k], At[m][k], acc[ai][bj][m][n], 0, 0, 0); __builtin_amdgcn_s_setprio(0); } while (0)
#define PG8_WAIT_V(n) asm volatile("s_waitcnt vmcnt(" #n ")" ::: "memory")
#define PG8_WAIT_L(n) asm volatile("s_waitcnt lgkmcnt(" #n ")" ::: "memory")
#define PG8_BAR __builtin_amdgcn_s_barrier()
#define PG8_SCHED __builtin_amdgcn_sched_barrier(0)
    Unit cur, nxt; int ui = 0;
    if (!S.next(0, cur)) return;
    f32x4 acc[2][2][4][2];
#pragma unroll
    for (int a = 0; a < 2; ++a)
#pragma unroll
        for (int b = 0; b < 2; ++b)
#pragma unroll
            for (int m = 0; m < 4; ++m)
#pragma unroll
                for (int n = 0; n < 2; ++n) acc[a][b][m][n] = (f32x4){0.f, 0.f, 0.f, 0.f};
    bf16x8 At[4][2], B0[2][2], B1[2][2];
    const char* cA = (const char*)g.A + (size_t)cur.pm * tstep; const char* cB = (const char*)g.Bt + (size_t)cur.pn * tstep;
    S.a_ready(cur);
    if constexpr (SP2) {
        PG8_STAGE(PG8_SB(0, 0), cB, voffB); PG8_STAGE(PG8_SB(0, 1), cB + hstep, voffB); PG8_STAGE(PG8_SA(0, 0), cA, voffA); PG8_STAGE(PG8_SA(0, 1), cA + hstep, voffA);
        if (wr == 1) PG8_BAR;
        PG8_WAIT_V(2); PG8_BAR;
        PG8_STAGE(PG8_SB(1, 0), cB + kstep, voffB); PG8_STAGE(PG8_SA(1, 0), cA + kstep, voffA); PG8_STAGE(PG8_SB(1, 1), cB + hstep + kstep, voffB);
        PG8_WAIT_V(6); PG8_BAR;
    } else {
        PG8_STAGE(PG8_SB(0, 0), cB, voffB); PG8_STAGE(PG8_SA(0, 0), cA, voffA); PG8_STAGE(PG8_SB(0, 1), cB + hstep, voffB); PG8_STAGE(PG8_SA(0, 1), cA + hstep, voffA);
        if (wr == 1) PG8_BAR;
        PG8_WAIT_V(4); PG8_BAR;
        PG8_STAGE(PG8_SB(1, 0), cB + kstep, voffB); PG8_STAGE(PG8_SA(1, 0), cA + kstep, voffA); PG8_STAGE(PG8_SB(1, 1), cB + hstep + kstep, voffB);
        PG8_WAIT_V(6); PG8_BAR;
    }
    for (;;) {
        const bool has_next = S.next(ui + 1, nxt);
        const char* nA = has_next ? (const char*)g.A + (size_t)nxt.pm * tstep : cA; const char* nB = has_next ? (const char*)g.Bt + (size_t)nxt.pn * tstep : cB;
        for (int t = 0; t < nt; t += 2) {
            const bool last = (t == nt - 2);
            const char* a1 = cA + (size_t)(t + 1) * kstep;
            const char* a2 = last ? nA : cA + (size_t)(t + 2) * kstep; const char* b2 = last ? nB : cB + (size_t)(t + 2) * kstep;
            const char* a3 = a2 + kstep; const char* b3 = b2 + kstep;
            if (last && has_next) S.a_ready(nxt);
            if constexpr (SP2) {
            PG8_LDB(B0, 0, 0); PG8_LDB(B1, 0, 1); PG8_SCHED; PG8_LDA(At, 0, 0); PG8_STAGE(PG8_SA(1, 1), a1 + hstep, voffA);
            PG8_WAIT_V(8); PG8_WAIT_L(0); PG8_BAR; PG8_MMA(0, 0, At, B0); PG8_MMA(0, 1, At, B1); PG8_BAR; PG8_SCHED;
            PG8_LDA(At, 0, 1); PG8_STAGE(PG8_SB(0, 0), b2, voffB); PG8_STAGE(PG8_SB(0, 1), b2 + hstep, voffB); PG8_STAGE(PG8_SA(0, 0), a2, voffA);
            PG8_WAIT_V(8); PG8_WAIT_L(0); PG8_BAR; PG8_MMA(1, 0, At, B0); PG8_MMA(1, 1, At, B1); PG8_BAR; PG8_SCHED;
            PG8_LDB(B0, 1, 0); PG8_LDB(B1, 1, 1); PG8_SCHED; PG8_LDA(At, 1, 0); PG8_STAGE(PG8_SA(0, 1), a2 + hstep, voffA);
            PG8_WAIT_V(8); PG8_WAIT_L(0); PG8_BAR; PG8_MMA(0, 0, At, B0); PG8_MMA(0, 1, At, B1); PG8_BAR; PG8_SCHED;
            PG8_LDA(At, 1, 1); PG8_STAGE(PG8_SB(1, 0), b3, voffB); PG8_STAGE(PG8_SB(1, 1), b3 + hstep, voffB); PG8_STAGE(PG8_SA(1, 0), a3, voffA);
            PG8_WAIT_V(8); PG8_WAIT_L(0); PG8_BAR; PG8_MMA(1, 0, At, B0); PG8_MMA(1, 1, At, B1); PG8_BAR; PG8_SCHED;
            } else {
            PG8_LDB(B0, 0, 0); PG8_SCHED; PG8_LDA(At, 0, 0); PG8_STAGE(PG8_SA(1, 1), a1 + hstep, voffA);
            PG8_WAIT_L(8); PG8_BAR; PG8_WAIT_L(0); PG8_MMA(0, 0, At, B0); PG8_BAR; PG8_SCHED;
            PG8_LDB(B1, 0, 1); PG8_STAGE(PG8_SB(0, 0), b2, voffB);
            PG8_BAR; PG8_WAIT_L(0); PG8_MMA(0, 1, At, B1); PG8_BAR;
            PG8_LDA(At, 0, 1); PG8_STAGE(PG8_SA(0, 0), a2, voffA);
            PG8_BAR; PG8_WAIT_L(0); PG8_MMA(1, 0, At, B0); PG8_BAR; PG8_SCHED;
            PG8_STAGE(PG8_SB(0, 1), b2 + hstep, voffB);
            PG8_WAIT_V(6); PG8_BAR; PG8_MMA(1, 1, At, B1); PG8_BAR;
            PG8_LDB(B0, 1, 0); PG8_SCHED; PG8_LDA(At, 1, 0); PG8_STAGE(PG8_SA(0, 1), a2 + hstep, voffA);
            PG8_WAIT_L(8); PG8_BAR; PG8_WAIT_L(0); PG8_MMA(0, 0, At, B0); PG8_BAR; PG8_SCHED;
            PG8_LDB(B1, 1, 1); PG8_STAGE(PG8_SB(1, 0), b3, voffB);
            PG8_BAR; PG8_WAIT_L(0); PG8_MMA(0, 1, At, B1); PG8_BAR;
            PG8_LDA(At, 1, 1); PG8_STAGE(PG8_SA(1, 0), a3, voffA);
            PG8_BAR; PG8_WAIT_L(0); PG8_MMA(1, 0, At, B0); PG8_BAR; PG8_SCHED;
            PG8_STAGE(PG8_SB(1, 1), b3 + hstep, voffB);
            PG8_WAIT_V(6); PG8_BAR; PG8_MMA(1, 1, At, B1); PG8_BAR;
            }
        }
        if constexpr (ALIGN_EPI) { if (wr == 0) PG8_BAR; }
        if constexpr (!Epi::AFTER_DRAIN) { E(acc, cur, wr, wc, fr, fq); S.done(cur); }
        if (!has_next) break;
#pragma unroll
        for (int a = 0; a < 2; ++a)
#pragma unroll
            for (int b = 0; b < 2; ++b)
#pragma unroll
                for (int m = 0; m < 4; ++m)
#pragma unroll
                    for (int n = 0; n < 2; ++n) acc[a][b][m][n] = (f32x4){0.f, 0.f, 0.f, 0.f};
        cur = nxt; cA = nA; cB = nB; ++ui;
        if constexpr (ALIGN_EPI) { if (wr == 1) PG8_BAR; }
    }
    PG8_WAIT_V(0);
    if constexpr (!ALIGN_EPI) { if (wr == 0) PG8_BAR; }
    PG8_BAR;
    if constexpr (Epi::AFTER_DRAIN) { E.fused(acc, cur, wr, wc, fr, fq, lds, wid, lane); S.done(cur); }
#undef PG8_SA
#undef PG8_SB
#undef PG8_STAGE
#undef PG8_LDA
#undef PG8_LDB
#undef PG8_MMA
#undef PG8_WAIT_V
#undef PG8_WAIT_L
#undef PG8_BAR
#undef PG8_SCHED
}
}
#define LAS __attribute__((address_space(3)))
#define XB_TMO      128
#define XB_XCNT(j)  (256  + 64 * (j))
#define XB_XSUB(j)  (1280 + 64 * (j))
#define XB_XGEN(j)  (2304 + 64 * (j))
#define XB_TOP      3328
#define XB_TOPGEN   3392
#define XCD_BAR_WORDS 3456
#define XB_SPIN_CAP (1u << 18)

__device__ __forceinline__ unsigned xb_ld(unsigned* p)              { return __hip_atomic_load(p, __ATOMIC_RELAXED, __HIP_MEMORY_SCOPE_AGENT); }
__device__ __forceinline__ unsigned xb_add(unsigned* p, unsigned v) { return __hip_atomic_fetch_add(p, v, __ATOMIC_RELAXED, __HIP_MEMORY_SCOPE_AGENT); }
__device__ __forceinline__ unsigned xb_xcc_id() { return (unsigned)__builtin_amdgcn_s_getreg((3 << 11) | 20) & 0xFu; }
#define XB_SPIN(cond, bar) do { unsigned _sp = 0; while (cond) { __builtin_amdgcn_s_sleep(1); \
    if ((++_sp & 255u) == 0u) { if (xb_ld(&(bar)[XB_TMO])) break; if (_sp > XB_SPIN_CAP) { atomicAdd(&(bar)[XB_TMO], 1u); break; } } } } while (0)

struct XcdBarrier {
    unsigned* bar; unsigned x;
    volatile LAS unsigned* st;
};

__device__ __forceinline__ XcdBarrier xcd_barrier_post(unsigned* bar, volatile LAS unsigned* st) {
    XcdBarrier b; b.bar = bar; b.x = xb_xcc_id(); b.st = st;
    if (threadIdx.x == 0) (void)xb_add(&bar[XB_XCNT(b.x)], 1u);
    return b;
}
__device__ __forceinline__ void xcd_barrier_complete(unsigned* bar, unsigned x, unsigned& nloc, unsigned& nx) {
    const unsigned G = gridDim.x * gridDim.y * gridDim.z;
    unsigned sum, cnt, mine, sp = 0u;
    for (;;) {
        sum = 0u; cnt = 0u; mine = 0u;
#pragma unroll
        for (unsigned j = 0; j < 16; ++j) { const unsigned c = xb_ld(&bar[XB_XCNT(j)]); sum += c; cnt += (c > 0u) ? 1u : 0u; mine = (j == x) ? c : mine; }
        if (sum == G) break;
        __builtin_amdgcn_s_sleep(1);
        if ((++sp & 255u) == 0u) { if (xb_ld(&bar[XB_TMO])) break; if (sp > XB_SPIN_CAP) { atomicAdd(&bar[XB_TMO], 1u); break; } }
    }
    nloc = mine > 0u ? mine : 1u; nx = cnt > 0u ? cnt : 1u;
}

__device__ __forceinline__ void xcd_barrier(const XcdBarrier& b) {
    asm volatile("s_waitcnt vmcnt(0)" ::: "memory");
    __syncthreads();
    if (threadIdx.x == 0) {
        unsigned* bar = b.bar;
        __builtin_amdgcn_s_waitcnt(0);
        unsigned nloc = b.st[0], nx = b.st[1];
        if (nloc == 0u) { xcd_barrier_complete(bar, b.x, nloc, nx); b.st[0] = nloc; b.st[1] = nx; }
        const unsigned old = xb_add(&bar[XB_XSUB(b.x)], 1u);
        const unsigned gen = old / nloc;
        if (old + 1u == (gen + 1u) * nloc) {
            __builtin_amdgcn_fence(__ATOMIC_RELEASE, "agent");
            asm volatile("s_waitcnt vmcnt(0)" ::: "memory");
            const unsigned og = xb_add(&bar[XB_TOP], 1u);
            const unsigned tg = og / nx;
            if (og + 1u == (tg + 1u) * nx) xb_add(&bar[XB_TOPGEN], 1u);
            else XB_SPIN(xb_ld(&bar[XB_TOPGEN]) == tg, bar);
            __builtin_amdgcn_fence(__ATOMIC_ACQUIRE, "agent");
            xb_add(&bar[XB_XGEN(b.x)], 1u);
            asm volatile("s_waitcnt vmcnt(0)" ::: "memory");
        } else {
            XB_SPIN(xb_ld(&bar[XB_XGEN(b.x)]) == gen, bar);
            __builtin_amdgcn_fence(__ATOMIC_ACQUIRE, "agent");
            asm volatile("s_waitcnt vmcnt(0)" ::: "memory");
        }
    }
    __syncthreads();
}
constexpr int BATCH = 2, SEQ = 4096, M = BATCH * SEQ, D = 2048, FF = 5632, DEPTH = 4, DIN = 5968, LDP = 6144, LDPP = 6208;
constexpr int NWAVES = 8;
constexpr int P_H = 0, P_GB = 512, P_GC = 1024, P_QB = 1536, P_KB = 2304, P_VB = 2432, P_QI = 2560, P_KI = 3584, P_QC = 3648, P_KC = 4416, P_VC = 5184, P_WI = 5952;
constexpr int Y_A = 0, Y_B = 512, Y_C = 1280;
constexpr float RMS_EPS = 1e-6f;
constexpr float SM_C = 0.08838834764831845f * 1.4426950408889634f;

constexpr size_t MiB = 1u << 20;
constexpr size_t WS_CTL = 0, CTL_ZERO_BYTES = 1 * MiB;
constexpr size_t WS_COSH = 1 * MiB, WS_SINH = 3 * MiB, WS_COSI = 5 * MiB, WS_SINI = 6 * MiB, WS_LSE = 7 * MiB, WS_RSS = 257 * MiB;
constexpr size_t WS_XN = 8 * MiB, WS_YMIX = 40 * MiB, WS_H = 72 * MiB, WS_PROJ = 160 * MiB, WS_SCORES = 258 * MiB, WS_W = 386 * MiB;
constexpr size_t WL_GU1 = 0, WL_D1 = 44 * MiB, WL_IN = 66 * MiB, WL_OUT = 90 * MiB, WL_GU2 = 98 * MiB, WL_D2 = 142 * MiB, WL_STRIDE = 164 * MiB;
constexpr size_t WS_END = WS_W + DEPTH * WL_STRIDE;
static_assert((size_t)M * FF * 2 <= WS_PROJ - WS_H && (size_t)M * LDPP * 2 <= WS_RSS - WS_PROJ && WS_RSS + (size_t)M * 32 * 4 <= WS_SCORES && (size_t)M * SEQ * 4 <= WS_W - WS_SCORES, "ws map");
static_assert((size_t)2 * FF * D * 2 <= WL_D1 && (size_t)D * FF * 2 <= WL_IN - WL_D1 && (size_t)LDP * D * 2 <= WL_OUT - WL_IN && (size_t)D * D * 2 <= WL_GU2 - WL_OUT, "weight map");
constexpr int CW_BAR = 4096;

constexpr int RING_BYTES = 131072, MISC_OFF = RING_BYTES + 320, LDS_BYTES = 147456;

typedef unsigned short bf16;
typedef unsigned v4u __attribute__((ext_vector_type(4)));
typedef unsigned v2u __attribute__((ext_vector_type(2)));
typedef float f32x4 __attribute__((ext_vector_type(4)));
typedef float f32x16 __attribute__((ext_vector_type(16)));
typedef short bf16x8 __attribute__((ext_vector_type(8)));
typedef short s16x4 __attribute__((ext_vector_type(4)));

__device__ __forceinline__ unsigned f2bf(float f) { unsigned u = __builtin_bit_cast(unsigned, f); return (u + 0x7fffu + ((u >> 16) & 1u)) >> 16; }
__device__ __forceinline__ unsigned pk2(float lo, float hi) { return f2bf(lo) | (f2bf(hi) << 16); }
__device__ __forceinline__ float bf_lo(unsigned w) { return __builtin_bit_cast(float, w << 16); }
__device__ __forceinline__ float bf_hi(unsigned w) { return __builtin_bit_cast(float, w & 0xffff0000u); }
__device__ __forceinline__ float bf2f(bf16 b) { return __builtin_bit_cast(float, (unsigned)b << 16); }
__device__ __forceinline__ float wave_sum(float v) {
#pragma unroll
    for (int o = 1; o < 64; o <<= 1) v += __shfl_xor(v, o);
    return v;
}

__device__ const float INV_H[64] = {
1.000000000e+00f, 8.659643531e-01f, 7.498942018e-01f, 6.493816376e-01f, 5.623413324e-01f, 4.869675338e-01f, 4.216965139e-01f, 3.651741147e-01f, 3.162277639e-01f, 2.738419771e-01f, 2.371373922e-01f, 2.053525001e-01f, 1.778279394e-01f, 1.539926529e-01f, 1.333521456e-01f, 1.154782027e-01f, 1.000000015e-01f, 8.659642935e-02f, 7.498941571e-02f, 6.493816525e-02f, 5.623412877e-02f, 4.869675264e-02f, 4.216964915e-02f, 3.651741147e-02f, 3.162277862e-02f, 2.738419734e-02f, 2.371373586e-02f, 2.053524926e-02f, 1.778279431e-02f, 1.539926510e-02f, 1.333521493e-02f, 1.154781971e-02f, 9.999999776e-03f, 8.659643121e-03f, 7.498942316e-03f, 6.493816618e-03f, 5.623413250e-03f, 4.869675264e-03f, 4.216964822e-03f, 3.651741426e-03f, 3.162277862e-03f, 2.738419687e-03f, 2.371373819e-03f, 2.053525066e-03f, 1.778279431e-03f, 1.539926627e-03f, 1.333521446e-03f, 1.154781901e-03f, 1.000000047e-03f, 8.659643354e-04f, 7.498941850e-04f, 6.493816618e-04f, 5.623413017e-04f, 4.869675031e-04f, 4.216965463e-04f, 3.651741135e-04f, 3.162277862e-04f, 2.738419571e-04f, 2.371373848e-04f, 2.053525241e-04f, 1.778279402e-04f, 1.539926452e-04f, 1.333521504e-04f, 1.154782076e-04f };

struct Frame {
    LAS unsigned char* lds;
    int tid, lane, wave, bid, G, gw, NGW;
    unsigned char* ws;
};

template <int MODE> __device__ __forceinline__ int rowmap(int n) {
    if (MODE == 1) return 256 * (n >> 7) + (n & 127);
    if (MODE == 2) return 256 * (n >> 7) + 128 + (n & 127);
    if (MODE == 3) return n < 3648 ? n : (n < 3664 ? P_WI + (n - 3648) : n - 16);
    return n;
}
template <int MODE> __device__ __forceinline__ void transpose_item(const float* W, int K, int N, bf16* WT, LAS float* scr, int item, int lane, const float* gain  ) {
    const int nblk = (N + 31) / 32, kb = item / nblk, nb = item % nblk, k0 = 64 * kb, n0 = 32 * nb;
    const int nn = n0 + (lane & 31); const bool nok = nn < N;
    const int c = lane & 7;
    float gv[8];
    if (gain) { const f32x4 g0 = *(const f32x4*)(gain + k0 + 8 * c), g1 = *(const f32x4*)(gain + k0 + 8 * c + 4); gv[0] = g0[0]; gv[1] = g0[1]; gv[2] = g0[2]; gv[3] = g0[3]; gv[4] = g1[0]; gv[5] = g1[1]; gv[6] = g1[2]; gv[7] = g1[3]; }
    else {
#pragma unroll
        for (int e = 0; e < 8; ++e) gv[e] = 1.0f; }
#pragma unroll 8
    for (int i = 0; i < 32; ++i) { const int kk = 2 * i + (lane >> 5); scr[kk * 33 + (lane & 31)] = nok ? W[(size_t)(k0 + kk) * N + nn] : 0.f; }
    asm volatile("s_waitcnt lgkmcnt(0)" ::: "memory");
#pragma unroll
    for (int j = 0; j < 4; ++j) { const int n = (lane >> 3) + 8 * j; const LAS float* s = scr + (8 * c) * 33 + n;
        v4u o; o.x = pk2(s[0 * 33] * gv[0], s[1 * 33] * gv[1]); o.y = pk2(s[2 * 33] * gv[2], s[3 * 33] * gv[3]); o.z = pk2(s[4 * 33] * gv[4], s[5 * 33] * gv[5]); o.w = pk2(s[6 * 33] * gv[6], s[7 * 33] * gv[7]);
        if (n0 + n < N) *(v4u*)(WT + (size_t)rowmap<MODE>(n0 + n) * K + k0 + 8 * c) = o; }
    asm volatile("s_waitcnt lgkmcnt(0)" ::: "memory");
}
__device__ __forceinline__ void sincos_d(double a, float& sn, float& cs) {
    const double k = __builtin_rint(a * 0.63661977236758134308);
    double r = __builtin_fma(-k, 1.57079632679489655800e+00, a); r = __builtin_fma(-k, 6.12323399573676603587e-17, r);
    const int q = (int)((long long)k & 3);
    const double r2 = r * r;
    double s = -1.0 / 39916800.0; s = s * r2 + 1.0 / 362880.0; s = s * r2 - 1.0 / 5040.0; s = s * r2 + 1.0 / 120.0; s = s * r2 - 1.0 / 6.0; s = s * r2 * r + r;
    double c = 1.0 / 479001600.0; c = c * r2 - 1.0 / 3628800.0; c = c * r2 + 1.0 / 40320.0; c = c * r2 - 1.0 / 720.0; c = c * r2 + 1.0 / 24.0; c = c * r2 - 0.5; c = c * r2 + 1.0;
    const double ss = (q & 1) ? c : s, cc = (q & 1) ? s : c;
    sn = (float)((q & 2) ? -ss : ss); cs = (float)(((q + 1) & 2) ? -cc : cc);
}
struct Args { const void* in[15]; float* out; unsigned char* ws; int ph_lo, ph_hi; };
#define IN_X ((const float*)args.in[0])
#define IN_POS ((const int*)args.in[1])
#define IN_N1 ((const float*)args.in[2])
#define IN_G1 ((const float*)args.in[3])
#define IN_U1 ((const float*)args.in[4])
#define IN_D1 ((const float*)args.in[5])
#define IN_NM ((const float*)args.in[6])
#define IN_WIN ((const float*)args.in[7])
#define IN_CW ((const float*)args.in[8])
#define IN_WOUT ((const float*)args.in[9])
#define IN_N2 ((const float*)args.in[10])
#define IN_G2 ((const float*)args.in[11])
#define IN_U2 ((const float*)args.in[12])
#define IN_D2 ((const float*)args.in[13])
#define IN_NF ((const float*)args.in[14])
__device__ __forceinline__ void prologue(Frame& F, const Args& args) {
    LAS float* scr = (LAS float*)(F.lds + F.wave * 16384);
    constexpr int I_G = (D / 64) * (FF / 32), I_D = (FF / 64) * (D / 32), I_IN = (D / 64) * ((DIN + 31) / 32), I_OUT = (D / 64) * (D / 32);
    constexpr int PER_LAYER = 4 * I_G + 2 * I_D + I_IN + I_OUT;
    for (int it = F.gw; it < DEPTH * PER_LAYER; it += F.NGW) {
        const int L = it / PER_LAYER; int r = it % PER_LAYER;
        unsigned char* wl = F.ws + WS_W + (size_t)L * WL_STRIDE;
        const size_t og = (size_t)L * D * FF, oin = (size_t)L * D * DIN, oout = (size_t)L * D * D;
        if (r < I_G) { transpose_item<1>(IN_G1 + og, D, FF, (bf16*)(wl + WL_GU1), scr, r, F.lane, IN_N1 + L * D); continue; } r -= I_G;
        if (r < I_G) { transpose_item<2>(IN_U1 + og, D, FF, (bf16*)(wl + WL_GU1), scr, r, F.lane, IN_N1 + L * D); continue; } r -= I_G;
        if (r < I_D) { transpose_item<0>(IN_D1 + og, FF, D, (bf16*)(wl + WL_D1), scr, r, F.lane, nullptr); continue; } r -= I_D;
        if (r < I_G) { transpose_item<1>(IN_G2 + og, D, FF, (bf16*)(wl + WL_GU2), scr, r, F.lane, IN_N2 + L * D); continue; } r -= I_G;
        if (r < I_G) { transpose_item<2>(IN_U2 + og, D, FF, (bf16*)(wl + WL_GU2), scr, r, F.lane, IN_N2 + L * D); continue; } r -= I_G;
        if (r < I_D) { transpose_item<0>(IN_D2 + og, FF, D, (bf16*)(wl + WL_D2), scr, r, F.lane, nullptr); continue; } r -= I_D;
        if (r < I_IN) { transpose_item<3>(IN_WIN + oin, D, DIN, (bf16*)(wl + WL_IN), scr, r, F.lane, IN_NM + L * D); continue; } r -= I_IN;
        transpose_item<0>(IN_WOUT + oout, D, D, (bf16*)(wl + WL_OUT), scr, r, F.lane, nullptr);
    }
    for (int L = 0; L < DEPTH; ++L) { v4u* p = (v4u*)(F.ws + WS_W + (size_t)L * WL_STRIDE + WL_IN + (size_t)DIN * D * 2);
        for (int i = F.gw * 64 + F.lane; i < (LDP - DIN) * D * 2 / 16; i += F.NGW * 64) p[i] = (v4u){0u, 0u, 0u, 0u}; }
    { bf16* xb = (bf16*)(F.ws + WS_XN); float* rss = (float*)(F.ws + WS_RSS);
      for (int m = F.gw; m < M; m += F.NGW) { const f32x4* xr = (const f32x4*)(IN_X + (size_t)m * D) + F.lane; v2u* o = (v2u*)(xb + (size_t)m * D) + F.lane; float s = 0.f;
#pragma unroll
          for (int j = 0; j < 8; ++j) { const f32x4 v = xr[64 * j]; s += (v.x * v.x + v.y * v.y) + (v.z * v.z + v.w * v.w); v2u w; w.x = pk2(v.x, v.y); w.y = pk2(v.z, v.w); o[64 * j] = w; }
          s = wave_sum(s);
          if (F.lane < 32) rss[(size_t)m * 32 + F.lane] = F.lane == 0 ? s : 0.f; } }
    float* cosh_ = (float*)(F.ws + WS_COSH); float* sinh_ = (float*)(F.ws + WS_SINH); float* cosi_ = (float*)(F.ws + WS_COSI); float* sini_ = (float*)(F.ws + WS_SINI);
    for (int m = F.gw; m < M; m += F.NGW) { const float p = (float)IN_POS[m];
        { const float a = p * INV_H[F.lane]; float s, c; sincos_d((double)a, s, c); cosh_[m * 64 + F.lane] = c; sinh_[m * 64 + F.lane] = s; }
        if (F.lane < 32) { const float a = p * INV_H[2 * F.lane]; float s, c; sincos_d((double)a, s, c); cosi_[m * 32 + F.lane] = c; sini_[m * 32 + F.lane] = s; } }
}

__device__ __forceinline__ void norm_phase(Frame& F, const float* x, const float* g, bf16* xn) {
    for (int m = F.gw; m < M; m += F.NGW) {
        const f32x4* xr = (const f32x4*)(x + (size_t)m * D) + F.lane; f32x4 v[8]; float s = 0.f;
#pragma unroll
        for (int j = 0; j < 8; ++j) { v[j] = xr[64 * j]; s += (v[j].x * v[j].x + v[j].y * v[j].y) + (v[j].z * v[j].z + v[j].w * v[j].w); }
        const float r = 1.0f / sqrtf(wave_sum(s) * (1.0f / D) + RMS_EPS);
        v2u* o = (v2u*)(xn + (size_t)m * D) + F.lane;
#pragma unroll
        for (int j = 0; j < 8; ++j) { const f32x4 gg = ((const f32x4*)g)[F.lane + 64 * j]; v2u w; w.x = pk2(v[j].x * r * gg.x, v[j].y * r * gg.y); w.y = pk2(v[j].z * r * gg.z, v[j].w * r * gg.w); o[64 * j] = w; }
    }
}
__device__ __forceinline__ void final_norm_phase(Frame& F, float* x, const float* g) {
    for (int m = F.gw; m < M; m += F.NGW) {
        f32x4* xr = (f32x4*)(x + (size_t)m * D) + F.lane; f32x4 v[8]; float s = 0.f;
#pragma unroll
        for (int j = 0; j < 8; ++j) { v[j] = xr[64 * j]; s += (v[j].x * v[j].x + v[j].y * v[j].y) + (v[j].z * v[j].z + v[j].w * v[j].w); }
        const float r = 1.0f / sqrtf(wave_sum(s) * (1.0f / D) + RMS_EPS);
#pragma unroll
        for (int j = 0; j < 8; ++j) { const f32x4 gg = ((const f32x4*)g)[F.lane + 64 * j]; xr[64 * j] = v[j] * r * gg; }
    }
}

__device__ __forceinline__ void unpack8(const v4u w, float (&f)[8]) { f[0] = bf_lo(w.x); f[1] = bf_hi(w.x); f[2] = bf_lo(w.y); f[3] = bf_hi(w.y); f[4] = bf_lo(w.z); f[5] = bf_hi(w.z); f[6] = bf_lo(w.w); f[7] = bf_hi(w.w); }
__device__ __forceinline__ v4u pack8(const float (&f)[8]) { v4u w; w.x = pk2(f[0], f[1]); w.y = pk2(f[2], f[3]); w.z = pk2(f[4], f[5]); w.w = pk2(f[6], f[7]); return w; }
__device__ __forceinline__ void rope8(bf16* p1, bf16* p2, const float (&c)[8], const float (&s)[8], float sc) {
    float a[8], b[8], o1[8], o2[8]; unpack8(*(const v4u*)p1, a); unpack8(*(const v4u*)p2, b);
#pragma unroll
    for (int j = 0; j < 8; ++j) { o1[j] = (a[j] * c[j] - b[j] * s[j]) * sc; o2[j] = (b[j] * c[j] + a[j] * s[j]) * sc; }
    *(v4u*)p1 = pack8(o1); *(v4u*)p2 = pack8(o2);
}
__device__ __forceinline__ void rope_conv_phase(Frame& F, bf16* proj, bf16* ymix, const float* convw  ) {
    const float* cosh_ = (const float*)(F.ws + WS_COSH); const float* sinh_ = (const float*)(F.ws + WS_SINH); const float* cosi_ = (const float*)(F.ws + WS_COSI); const float* sini_ = (const float*)(F.ws + WS_SINI);
    const int lane = F.lane;
    float cw0[8], cw1[8], cw2[8];
#pragma unroll
    for (int j = 0; j < 8; ++j) { cw0[j] = convw[8 * lane + j]; cw1[j] = convw[512 + 8 * lane + j]; cw2[j] = convw[1024 + 8 * lane + j]; }
    for (int m = F.gw; m < M; m += F.NGW) {
        bf16* row = proj + (size_t)m * LDPP;
        { const int d8 = 8 * (lane & 7), hs = lane >> 3; float c[8], s[8];
          { const f32x4 c0 = *(const f32x4*)(cosh_ + m * 64 + d8), c1 = *(const f32x4*)(cosh_ + m * 64 + d8 + 4), s0 = *(const f32x4*)(sinh_ + m * 64 + d8), s1 = *(const f32x4*)(sinh_ + m * 64 + d8 + 4);
#pragma unroll
            for (int j = 0; j < 4; ++j) { c[j] = c0[j]; c[4 + j] = c1[j]; s[j] = s0[j]; s[4 + j] = s1[j]; } }
#pragma unroll
          for (int ps = 0; ps < 3; ++ps) { const int hd = ps * 8 + hs;
              if (hd < 19) { const int base = hd < 6 ? P_QB + hd * 128 : (hd == 6 ? P_KB : (hd < 13 ? P_QC + (hd - 7) * 128 : P_KC + (hd - 13) * 128));
                  rope8(row + base + d8, row + base + 64 + d8, c, s, 1.0f); } } }
        { const int d8 = 8 * (lane & 3), hd = lane >> 2; float c[8], s[8];
          { const f32x4 c0 = *(const f32x4*)(cosi_ + m * 32 + d8), c1 = *(const f32x4*)(cosi_ + m * 32 + d8 + 4), s0 = *(const f32x4*)(sini_ + m * 32 + d8), s1 = *(const f32x4*)(sini_ + m * 32 + d8 + 4);
#pragma unroll
            for (int j = 0; j < 4; ++j) { c[j] = c0[j]; c[4 + j] = c1[j]; s[j] = s0[j]; s[4 + j] = s1[j]; } }
          rope8(row + P_QI + hd * 64 + d8, row + P_QI + hd * 64 + 32 + d8, c, s, 0.125f);
          if (lane < 4) rope8(row + P_KI + d8, row + P_KI + 32 + d8, c, s, 1.0f); }
        { const int t = m & (SEQ - 1), ch = 8 * lane; float h0[8], g0[8], h1[8], g1[8], h2[8], g2[8], gb[8], y[8];
          unpack8(*(const v4u*)(row + P_H + ch), h0); unpack8(*(const v4u*)(row + P_GC + ch), g0); unpack8(*(const v4u*)(row + P_GB + ch), gb);
          if (t >= 1) { unpack8(*(const v4u*)(row - LDPP + P_H + ch), h1); unpack8(*(const v4u*)(row - LDPP + P_GC + ch), g1); } else {
#pragma unroll
              for (int j = 0; j < 8; ++j) { h1[j] = 0.f; g1[j] = 0.f; } }
          if (t >= 2) { unpack8(*(const v4u*)(row - 2 * LDPP + P_H + ch), h2); unpack8(*(const v4u*)(row - 2 * LDPP + P_GC + ch), g2); } else {
#pragma unroll
              for (int j = 0; j < 8; ++j) { h2[j] = 0.f; g2[j] = 0.f; } }
#pragma unroll
          for (int j = 0; j < 8; ++j) y[j] = gb[j] * (cw0[j] * (g2[j] * h2[j]) + cw1[j] * (g1[j] * h1[j]) + cw2[j] * (g0[j] * h0[j]));
          *(v4u*)(ymix + (size_t)m * D + Y_A + ch) = pack8(y); }
    }
}

__device__ __forceinline__ int crow(int r, int hi) { return (r & 3) + 8 * (r >> 2) + 4 * hi; }
constexpr int VROW = 320;
constexpr int VTILE = 32 * VROW;
struct AttnSt { f32x16 o[4]; float m, l; };
__device__ __forceinline__ void attn_init(AttnSt& st) {
#pragma unroll
    for (int d = 0; d < 4; ++d)
#pragma unroll
        for (int r = 0; r < 16; ++r) st.o[d][r] = 0.f;
    st.m = -1e30f; st.l = 0.f;
}
__device__ __forceinline__ s16x4 vtr(const LAS unsigned char* p) { return __builtin_bit_cast(s16x4, __builtin_amdgcn_ds_read_tr16_b64_v4i16((LAS s16x4*)p)); }
__device__ __forceinline__ void attn_tile(AttnSt& st, const bf16x8 (&qf)[8], const bf16* kp, const bf16* vp, LAS unsigned char* vl, unsigned vmask, int lane) {
    const int r32 = lane & 31, hi = lane >> 5;
    bf16x8 kf[8], vv[4];
#pragma unroll
    for (int ks = 0; ks < 8; ++ks) kf[ks] = *(const bf16x8*)(kp + ks * 16);
#pragma unroll
    for (int i = 0; i < 4; ++i) vv[i] = *(const bf16x8*)(vp + i * 16);
    f32x16 s;
#pragma unroll
    for (int r = 0; r < 16; ++r) s[r] = 0.f;
#pragma unroll
    for (int ks = 0; ks < 8; ++ks) s = __builtin_amdgcn_mfma_f32_32x32x16_bf16(kf[ks], qf[ks], s, 0, 0, 0);
#pragma unroll
    for (int i = 0; i < 4; ++i) *(LAS bf16x8*)(vl + r32 * VROW + (hi + 2 * i) * 16) = vv[i];
    asm volatile("" ::: "memory");
#pragma unroll
    for (int i = 0; i < 4; ++i) vv[i] = *(const bf16x8*)(vp + (i + 4) * 16);
#pragma unroll
    for (int i = 0; i < 4; ++i) *(LAS bf16x8*)(vl + r32 * VROW + (hi + 2 * (i + 4)) * 16) = vv[i];
    __builtin_amdgcn_sched_barrier(0);
    float mx = -INFINITY;
#pragma unroll
    for (int r = 0; r < 16; ++r) { s[r] = ((vmask >> r) & 1u) ? s[r] : -INFINITY; mx = fmaxf(mx, s[r]); }
    mx = fmaxf(mx, __shfl_xor(mx, 32));
    const float mn = fmaxf(st.m, mx), alpha = __builtin_amdgcn_exp2f((st.m - mn) * SM_C), mc = -mn * SM_C;
    st.m = mn;
    float ps = 0.f;
#pragma unroll
    for (int r = 0; r < 16; ++r) { s[r] = __builtin_amdgcn_exp2f(fmaf(s[r], SM_C, mc)); ps += s[r]; }
    st.l = st.l * alpha + ps;
#pragma unroll
    for (int d = 0; d < 4; ++d) st.o[d] = st.o[d] * alpha;
    bf16x8 pf[2];
#pragma unroll
    for (int sx = 0; sx < 2; ++sx) { v4u w; w.x = pk2(s[8 * sx + 0], s[8 * sx + 1]); w.y = pk2(s[8 * sx + 2], s[8 * sx + 3]); w.z = pk2(s[8 * sx + 4], s[8 * sx + 5]); w.w = pk2(s[8 * sx + 6], s[8 * sx + 7]); pf[sx] = __builtin_bit_cast(bf16x8, w); }
    __builtin_amdgcn_sched_barrier(0);
    const int g4 = lane >> 4, qq = (lane >> 2) & 3, pp = lane & 3;
    const LAS unsigned char* vb = vl + (4 * (g4 >> 1) + qq) * VROW + (16 * (g4 & 1) + 4 * pp) * 2;
#pragma unroll
    for (int d = 0; d < 4; ++d)
#pragma unroll
        for (int sx = 0; sx < 2; ++sx) { const s16x4 lo = vtr(vb + (16 * sx) * VROW + 64 * d), h8 = vtr(vb + (16 * sx + 8) * VROW + 64 * d);
            const bf16x8 a = (bf16x8){lo[0], lo[1], lo[2], lo[3], h8[0], h8[1], h8[2], h8[3]};
            st.o[d] = __builtin_amdgcn_mfma_f32_32x32x16_bf16(a, pf[sx], st.o[d], 0, 0, 0); if (sx == 1) __builtin_amdgcn_sched_barrier(0); }
}

__device__ __forceinline__ void indexer_unit(Frame& F, const bf16* proj, float* scores, int b, int tt, int kc) {
    const int lane = F.lane, r32 = lane & 31, hi = lane >> 5;
    const int t0 = tt * 64 + F.wave * 8;
    bf16x8 qa[4][4]; float wv[4][16];
    { const int tsel = (r32 >> 2) & 1, head = 4 * (r32 >> 3) + (r32 & 3);
#pragma unroll
      for (int a = 0; a < 4; ++a) { const bf16* qp = proj + (size_t)(b * SEQ + t0 + 2 * a + tsel) * LDPP + P_QI + head * 64 + hi * 8;
#pragma unroll
          for (int ks = 0; ks < 4; ++ks) qa[a][ks] = *(const bf16x8*)(qp + ks * 16);
          const v4u* wp = (const v4u*)(proj + (size_t)(b * SEQ + t0 + 2 * a + hi) * LDPP + P_WI); const v4u w0 = wp[0], w1 = wp[1];
          const unsigned ww[8] = {w0.x, w0.y, w0.z, w0.w, w1.x, w1.y, w1.z, w1.w};
#pragma unroll
          for (int j = 0; j < 8; ++j) { wv[a][2 * j] = 0.25f * bf_lo(ww[j]); wv[a][2 * j + 1] = 0.25f * bf_hi(ww[j]); } } }
    for (int kt = 0; kt < 8; ++kt) {
        const int k0 = kc * 256 + kt * 32;
        const bf16* kp = proj + (size_t)(b * SEQ + k0 + r32) * LDPP + P_KI + hi * 8;
        bf16x8 kf[4];
#pragma unroll
        for (int ks = 0; ks < 4; ++ks) kf[ks] = *(const bf16x8*)(kp + ks * 16);
#pragma unroll
        for (int a = 0; a < 4; ++a) { f32x16 acc;
#pragma unroll
            for (int r = 0; r < 16; ++r) acc[r] = 0.f;
#pragma unroll
            for (int ks = 0; ks < 4; ++ks) acc = __builtin_amdgcn_mfma_f32_32x32x16_bf16(qa[a][ks], kf[ks], acc, 0, 0, 0);
            float sc = 0.f;
#pragma unroll
            for (int r = 0; r < 16; ++r) sc = fmaf(wv[a][r], fmaxf(acc[r], 0.f), sc);
            scores[(size_t)(b * SEQ + t0 + 2 * a + hi) * SEQ + k0 + r32] = sc; }
    }
}
__device__ __forceinline__ void dilated_unit(Frame& F, const bf16* proj, bf16* ymix, float* lse, int wu) {
    const int lane = F.lane, r32 = lane & 31, hi = lane >> 5;
    const int b = wu / 768; int rem = wu % 768; const int g = rem >> 8; rem &= 255; const int hh = rem >> 7, ti = rem & 127;
    const int sh = 2 * g, dl = 1 << sh, tpc = 128 >> sh;
    const int r = ti / tpc, i0 = (ti % tpc) * 32, hd = g * 2 + hh;
    LAS unsigned char* vl = F.lds + F.wave * VTILE;
    const int tq = r + dl * (i0 + r32);
    bf16x8 qf[8];
    { const bf16* qp = proj + (size_t)(b * SEQ + tq) * LDPP + P_QC + hd * 128 + hi * 8;
#pragma unroll
      for (int ks = 0; ks < 8; ++ks) qf[ks] = *(const bf16x8*)(qp + ks * 16); }
    AttnSt st; attn_init(st);
    for (int kt = 0; kt < 5; ++kt) {
        const int ib = i0 - 128 + 32 * kt;
        if (ib + 31 < 0) continue;
        const int ik = ib + r32, ikc = ik < 0 ? 0 : ik;
        const bf16* rowp = proj + (size_t)(b * SEQ + r + dl * ikc) * LDPP + hd * 128 + hi * 8;
        unsigned vmask = 0u; const int iq = i0 + r32;
#pragma unroll
        for (int rr = 0; rr < 16; ++rr) { const int ikey = ib + crow(rr, hi); vmask |= (ikey >= 0 && ikey <= iq && ikey >= iq - 128) ? (1u << rr) : 0u; }
        attn_tile(st, qf, rowp + P_KC, rowp + P_VC, vl, vmask, lane);
    }
    const float lt = st.l + __shfl_xor(st.l, 32), inv = 1.0f / lt;
    bf16* op = ymix + (size_t)(b * SEQ + tq) * D + Y_C + hd * 128;
#pragma unroll
    for (int d = 0; d < 4; ++d)
#pragma unroll
        for (int r4 = 0; r4 < 4; ++r4) { v2u w; w.x = pk2(st.o[d][4 * r4] * inv, st.o[d][4 * r4 + 1] * inv); w.y = pk2(st.o[d][4 * r4 + 2] * inv, st.o[d][4 * r4 + 3] * inv);
            *(v2u*)(op + 32 * d + 8 * r4 + 4 * hi) = w; }
    if (hi == 0) lse[(size_t)(b * SEQ + tq) * 6 + hd] = st.m * SM_C + __builtin_amdgcn_logf(lt);
}
constexpr int N_IDX_UNITS = 2 * 544, N_DIL_WU = 2 * 3 * 2 * 128, N_P6_UNITS = N_IDX_UNITS + N_DIL_WU / NWAVES;
__device__ __forceinline__ void p6_phase(Frame& F, const bf16* proj, bf16* ymix, float* scores, float* lse) {
    for (int u = F.bid; u < N_P6_UNITS; u += F.G) {
        if (u < N_IDX_UNITS) { const int b = u / 544; int r = u % 544; int q = 0; while (r >= 4 * (q + 1)) { r -= 4 * (q + 1); ++q; }
            const int tt = 4 * q + r / (q + 1), kc = r % (q + 1);
            indexer_unit(F, proj, scores, b, tt, kc); }
        else dilated_unit(F, proj, ymix, lse, (u - N_IDX_UNITS) * NWAVES + F.wave);
    }
}

constexpr int VROW2 = 288;
using pg8::swap16; using pg8::swap32; using pg8::xadd16; using pg8::xadd32;
__device__ __forceinline__ float xmax16(float v) { float a = v, b = v; swap16(a, b); return fmaxf(a, b); }
__device__ __forceinline__ float xmax32(float v) { float a = v, b = v; swap32(a, b); return fmaxf(a, b); }
__device__ __forceinline__ void dsa_attn(Frame& F, const bf16* proj, bf16* ymix, int m, int b, int nsel, LAS int* list, LAS unsigned char* vl) {
    const int lane = F.lane, c16 = lane & 15, g = lane >> 4, r32 = lane & 31, hi = lane >> 5;
    bf16x8 qf[4];
    { const bf16* qp = proj + (size_t)m * LDPP + P_QB + (c16 < 6 ? c16 : 0) * 128 + 8 * g;
#pragma unroll
      for (int ks = 0; ks < 4; ++ks) { qf[ks] = *(const bf16x8*)(qp + 32 * ks); if (c16 >= 6) qf[ks] = (bf16x8){0, 0, 0, 0, 0, 0, 0, 0}; } }
    f32x4 o[8];
#pragma unroll
    for (int d = 0; d < 8; ++d) o[d] = (f32x4){0.f, 0.f, 0.f, 0.f};
    float mrun = -1e30f, lrun = 0.f;
    const int ntile = (nsel + 31) >> 5;
    const bf16* kvb = proj + (size_t)(b * SEQ) * LDPP;
    bf16x8 ka[8], kb8[8], vv[8];
    const LAS unsigned char* vb = vl + (4 * g + (c16 >> 2)) * VROW2 + (4 * (c16 & 3)) * 2;
#define DSA_LOADK(KDST, KT) do { const int s0_ = (KT) * 32 + c16, s1_ = s0_ + 16; k0_ = s0_ < nsel ? list[s0_] : 0; k1_ = s1_ < nsel ? list[s1_] : 0; \
        const bf16* p0_ = kvb + (size_t)k0_ * LDPP + P_KB + 8 * g; const bf16* p1_ = kvb + (size_t)k1_ * LDPP + P_KB + 8 * g; \
        _Pragma("unroll") for (int ks = 0; ks < 4; ++ks) { KDST[ks] = *(const bf16x8*)(p0_ + 32 * ks); KDST[4 + ks] = *(const bf16x8*)(p1_ + 32 * ks); } } while (0)
#define DSA_LOADV() do { const bf16* vp_ = kvb + (size_t)((lane & 16) ? k1_ : k0_) * LDPP + P_VB + 8 * hi; \
        _Pragma("unroll") for (int i = 0; i < 8; ++i) vv[i] = *(const bf16x8*)(vp_ + 16 * i); } while (0)
#define DSA_TILE(KCUR, KNXT, KT) do { \
        const int ktn_ = (KT) + 1 < ntile ? (KT) + 1 : (KT); \
        DSA_LOADK(KNXT, ktn_); \
        __builtin_amdgcn_sched_barrier(0); \
        f32x4 sa = (f32x4){0.f, 0.f, 0.f, 0.f}, sb = (f32x4){0.f, 0.f, 0.f, 0.f}; \
        _Pragma("unroll") for (int ks = 0; ks < 4; ++ks) { sa = __builtin_amdgcn_mfma_f32_16x16x32_bf16(KCUR[ks], qf[ks], sa, 0, 0, 0); sb = __builtin_amdgcn_mfma_f32_16x16x32_bf16(KCUR[4 + ks], qf[ks], sb, 0, 0, 0); } \
        _Pragma("unroll") for (int i = 0; i < 8; ++i) *(LAS bf16x8*)(vl + r32 * VROW2 + (hi + 2 * i) * 16) = vv[i]; \
        DSA_LOADV(); \
        __builtin_amdgcn_sched_barrier(0); \
        const int kb_ = (KT) * 32 + 4 * g; float mx = -INFINITY; \
        _Pragma("unroll") for (int j = 0; j < 4; ++j) { sa[j] = (kb_ + j < nsel) ? sa[j] : -INFINITY; sb[j] = (kb_ + 16 + j < nsel) ? sb[j] : -INFINITY; mx = fmaxf(mx, fmaxf(sa[j], sb[j])); } \
        mx = xmax16(mx); mx = xmax32(mx); \
        const float mn = fmaxf(mrun, mx), alpha = __builtin_amdgcn_exp2f((mrun - mn) * SM_C), mc = -mn * SM_C; mrun = mn; \
        float ps = 0.f; \
        _Pragma("unroll") for (int j = 0; j < 4; ++j) { sa[j] = __builtin_amdgcn_exp2f(fmaf(sa[j], SM_C, mc)); sb[j] = __builtin_amdgcn_exp2f(fmaf(sb[j], SM_C, mc)); ps += sa[j] + sb[j]; } \
        lrun = lrun * alpha + ps; \
        _Pragma("unroll") for (int d = 0; d < 8; ++d) o[d] = o[d] * alpha; \
        v4u pw; pw.x = pk2(sa[0], sa[1]); pw.y = pk2(sa[2], sa[3]); pw.z = pk2(sb[0], sb[1]); pw.w = pk2(sb[2], sb[3]); \
        const bf16x8 pf = __builtin_bit_cast(bf16x8, pw); \
        _Pragma("unroll") for (int d = 0; d < 8; ++d) { const s16x4 lo = vtr(vb + 32 * d), h8 = vtr(vb + 16 * VROW2 + 32 * d); \
            const bf16x8 a = (bf16x8){lo[0], lo[1], lo[2], lo[3], h8[0], h8[1], h8[2], h8[3]}; \
            o[d] = __builtin_amdgcn_mfma_f32_16x16x32_bf16(a, pf, o[d], 0, 0, 0); } \
        __builtin_amdgcn_sched_barrier(0); } while (0)
    int k0_, k1_;
    DSA_LOADK(ka, 0); DSA_LOADV();
    for (int kt = 0; kt < ntile; kt += 2) {
        DSA_TILE(ka, kb8, kt);
        if (kt + 1 < ntile) DSA_TILE(kb8, ka, kt + 1);
    }
#undef DSA_TILE
#undef DSA_LOADV
#undef DSA_LOADK
    const float lt = xadd32(xadd16(lrun)), inv = 1.0f / lt;
    if (c16 < 6) { bf16* op = ymix + (size_t)m * D + Y_B + c16 * 128 + 4 * g;
#pragma unroll
        for (int d = 0; d < 8; ++d) { v2u w; w.x = pk2(o[d][0] * inv, o[d][1] * inv); w.y = pk2(o[d][2] * inv, o[d][3] * inv); *(v2u*)(op + 16 * d) = w; } }
}

__device__ __forceinline__ unsigned f2ord(float f) { const unsigned b = __builtin_bit_cast(unsigned, f); return b ^ ((unsigned)((int)b >> 31) | 0x80000000u); }
typedef unsigned short u16x2 __attribute__((ext_vector_type(2)));
__device__ __forceinline__ int wave_sum_i(int v) {
    v += __builtin_amdgcn_update_dpp(0, v, 0xB1, 0xF, 0xF, false);
    v += __builtin_amdgcn_update_dpp(0, v, 0x4E, 0xF, 0xF, false);
    v += __builtin_amdgcn_update_dpp(0, v, 0x141, 0xF, 0xF, false);
    v += __builtin_amdgcn_update_dpp(0, v, 0x140, 0xF, 0xF, false);
    return __builtin_amdgcn_readlane(v, 0) + __builtin_amdgcn_readlane(v, 16) + __builtin_amdgcn_readlane(v, 32) + __builtin_amdgcn_readlane(v, 48);
}
__device__ __forceinline__ unsigned pk_count_gt(unsigned acc, unsigned h, unsigned C, unsigned one2) {
    unsigned d; asm("v_pk_sub_u16 %0, %1, %2 clamp\n\tv_pk_min_u16 %0, %0, %3\n\tv_pk_add_u16 %0, %0, %4" : "=&v"(d) : "v"(h), "v"(C), "v"(one2), "v"(acc)); return d; }
__device__ __forceinline__ int lane_prefix(unsigned long long mask) { return __builtin_amdgcn_mbcnt_hi((unsigned)(mask >> 32), __builtin_amdgcn_mbcnt_lo((unsigned)mask, 0u)); }
__device__ __forceinline__ void p7_phase(Frame& F, const bf16* proj, bf16* ymix, const float* scores, const float* lse, const int pmode  ) {
    const int lane = F.lane;
    LAS unsigned char* vl = F.lds + F.wave * VTILE;
    LAS int* list = (LAS int*)(F.lds + NWAVES * VTILE + F.wave * 2048);
    LAS unsigned* cand = (LAS unsigned*)(F.lds + NWAVES * VTILE + F.wave * 2048 + 1024);
    const int per_b = F.NGW >> 1;
    for (int it = (F.bid >> 1) * NWAVES + F.wave; it < SEQ; it += per_b) {
        const int b = F.bid & 1, t = it, m = b * SEQ + t;
        int ln = lane; asm volatile("" : "+v"(ln));
        { float ls[6];
#pragma unroll
          for (int i = 0; i < 6; ++i) ls[i] = lse[(size_t)m * 6 + i];
          unsigned* yc = (unsigned*)(ymix + (size_t)m * D + Y_C);
#pragma unroll
          for (int hh = 0; hh < 2; ++hh) { const float mx = fmaxf(ls[hh], fmaxf(ls[2 + hh], ls[4 + hh]));
              const float e0 = __builtin_amdgcn_exp2f(ls[hh] - mx), e1 = __builtin_amdgcn_exp2f(ls[2 + hh] - mx), e2 = __builtin_amdgcn_exp2f(ls[4 + hh] - mx), rs = 1.0f / (e0 + e1 + e2);
              const float al[3] = {e0 * rs, e1 * rs, e2 * rs};
#pragma unroll
              for (int g = 0; g < 3; ++g) { const int idx = (g * 2 + hh) * 64 + lane; const unsigned w = yc[idx]; yc[idx] = pk2(bf_lo(w) * al[g], bf_hi(w) * al[g]); } } }
        unsigned u[64];
        { const float* sp = scores + (size_t)m * SEQ + ln; float f[64];
#pragma unroll
          for (int j = 0; j < 32; ++j) f[j] = sp[j * 64];
          if (t >= 2048) {
#pragma unroll
              for (int j = 32; j < 64; ++j) f[j] = sp[j * 64];
          } else {
#pragma unroll
              for (int j = 32; j < 64; ++j) f[j] = 0.f;
          }
#pragma unroll
          for (int j = 0; j < 64; ++j) u[j] = (ln <= t - j * 64) ? f2ord(f[j]) : 0u; }
        unsigned B = 0u; int need = 0, nb = 0;
        if (t + 1 > 256 && !(pmode & 2)) {
            unsigned h[32];
#pragma unroll
            for (int jj = 0; jj < 32; ++jj) h[jj] = (u[2 * jj] >> 16) | (u[2 * jj + 1] & 0xffff0000u);
            int cge = t + 1, cgt = 0;
            for (int bit = 15; bit >= 0; --bit) {
                const unsigned cnd = B | (1u << bit), cm1 = cnd - 1u;
                const unsigned C = cm1 | (cm1 << 16), one2 = 0x00010001u;
                unsigned acc = 0u;
#pragma unroll
                for (int jj = 0; jj < 32; ++jj) acc = pk_count_gt(acc, h[jj], C, one2);
                const unsigned a = acc;
                const int cnt = wave_sum_i((int)((a & 0xffffu) + (a >> 16)));
                if (cnt >= 256) { B = cnd; cge = cnt; } else cgt = cgt;
            }
            { const unsigned C = B | (B << 16), one2 = 0x00010001u; unsigned acc = 0u;
#pragma unroll
              for (int jj = 0; jj < 32; ++jj) acc = pk_count_gt(acc, h[jj], C, one2);
              const unsigned a = acc; cgt = wave_sum_i((int)((a & 0xffffu) + (a >> 16))); }
            need = 256 - cgt; nb = cge - cgt;
        }
        int nsel = 0, ncand = 0;
#pragma unroll
        for (int j = 0; j < 64; ++j) {
            const unsigned hv = u[j] >> 16;
            const bool gt = hv > B;
            const unsigned long long mg = __ballot(gt);
            if (gt) list[nsel + lane_prefix(mg)] = j * 64 + ln;
            nsel += __popcll(mg);
            if (B != 0u) { const bool eq = hv == B; const unsigned long long me = __ballot(eq);
                if (me != 0ull) { const int p = ncand + lane_prefix(me); if (eq && p < 64) { cand[2 * p] = u[j]; cand[2 * p + 1] = (unsigned)(j * 64 + ln); } ncand += __popcll(me); } }
            if ((j & 3) == 3) __builtin_amdgcn_sched_barrier(0);
        }
        if (need > 0) {
            const int nc = ncand < 64 ? ncand : 64;
            const unsigned cv = lane < nc ? cand[2 * lane] : 0u, ck = lane < nc ? cand[2 * lane + 1] : 0xffffffffu;
            int rank = 0;
            for (int j = 0; j < nc; ++j) { const unsigned sv = __builtin_amdgcn_readlane(cv, j), sk = __builtin_amdgcn_readlane(ck, j); rank += (sv > cv || (sv == cv && sk < ck)) ? 1 : 0; }
            const bool take = lane < nc && rank < need;
            const unsigned long long mt = __ballot(take);
            if (take) list[nsel + lane_prefix(mt)] = (int)ck;
            nsel += __popcll(mt);
        }
        if (pmode & 2) nsel = nsel > 256 ? 256 : nsel;
        (void)nb;
        if (!(pmode & 1)) dsa_attn(F, proj, ymix, m, b, nsel, list, vl);
    }
}

constexpr int PH_PRO = 0, PH_PER_LAYER = 9, PH_FINAL = 1 + DEPTH * PH_PER_LAYER, N_PHASES = PH_FINAL + 1;
__global__ void __launch_bounds__(NWAVES * 64, 2) fwd_kernel(Args args) {
    extern __shared__ __attribute__((aligned(16))) unsigned char lds[];
    Frame F;
    F.lds = (LAS unsigned char*)lds; F.tid = threadIdx.x; F.lane = F.tid & 63; F.wave = __builtin_amdgcn_readfirstlane(F.tid >> 6); F.bid = blockIdx.x;
    const int wave0 = F.wave;
    F.G = gridDim.x; F.gw = blockIdx.x * NWAVES + F.wave; F.NGW = F.G * NWAVES; F.ws = args.ws;
    volatile LAS unsigned* MISC = (volatile LAS unsigned*)(F.lds + MISC_OFF);
    for (int i = F.tid; i < (LDS_BYTES - RING_BYTES) / 4; i += NWAVES * 64) ((LAS unsigned*)(F.lds + RING_BYTES))[i] = 0u;
    __syncthreads();
    const int lo = args.ph_lo, hi = args.ph_hi;
    XcdBarrier bar; bar.bar = (unsigned*)(args.ws + WS_CTL) + CW_BAR; bar.x = 0; bar.st = nullptr;
    if (hi - lo > 1) bar = xcd_barrier_post((unsigned*)(args.ws + WS_CTL) + CW_BAR, MISC + 8);
#define IN(k) (lo <= (k) && (k) < hi)
#ifndef PHMASK
#define PHMASK 0xFFFF
#endif
#define PHM(b) ((PHMASK >> (b)) & 1)
#define RELANE() do { int w_ = wave0, b_ = blockIdx.x; asm volatile("" : "+s"(w_), "+s"(b_)); int l_; asm volatile("v_mbcnt_lo_u32_b32 %0, -1, 0\n\tv_mbcnt_hi_u32_b32 %0, -1, %0" : "=v"(l_)); F.wave = w_; F.bid = b_; F.lane = l_; F.tid = w_ * 64 + l_; F.gw = b_ * NWAVES + w_; } while (0)
#define SEAM(k) do { if (IN(k) && IN((k) + 1)) xcd_barrier(bar); } while (0)
    float* X = args.out;
    bf16* XB = (bf16*)(args.ws + WS_XN); float* RSS = (float*)(args.ws + WS_RSS); bf16* YMIX = (bf16*)(args.ws + WS_YMIX); bf16* HB = (bf16*)(args.ws + WS_H); bf16* PROJ = (bf16*)(args.ws + WS_PROJ);
    float* SCORES = (float*)(args.ws + WS_SCORES); float* LSE = (float*)(args.ws + WS_LSE);

#ifndef PROBEMASK
#define PROBEMASK 0
#endif
#ifndef PROBE_NX
#define PROBE_NX 4
#endif
#define XPM(b) ((PROBEMASK >> (b)) & 1)
#ifndef PROBE_P7MODE
#define PROBE_P7MODE 0
#endif
#define PHASE(k, b, ...) do { if (PHM(b) && (extra ? XPM(b) : IN(k))) { RELANE(); __VA_ARGS__ } if (extra ? XPM(b) : (IN(k) && IN((k) + 1))) xcd_barrier(bar); } while (0)
    { for (int r_ = 0; r_ < 1 + XPM(0) * PROBE_NX; ++r_) { if (r_) xcd_barrier(bar); if (PHM(0) && IN(PH_PRO)) { RELANE(); prologue(F, args); } } SEAM(PH_PRO); }

    for (int Lx = 0; Lx < DEPTH + (PROBEMASK ? PROBE_NX : 0); ++Lx) {
        const bool extra = Lx >= DEPTH; const int L = extra ? DEPTH - 1 : Lx;
        const int pb = 1 + L * PH_PER_LAYER;
        if (!extra && (hi <= pb || lo >= pb + PH_PER_LAYER)) continue;
        if (extra && !IN(PH_FINAL)) continue;
        const float rs = extra ? 0.f : 1.f;
        unsigned char* wl = args.ws + WS_W + (size_t)L * WL_STRIDE;
        PHASE(pb + 0, 2, pg8::Gemm g{XB, (const bf16*)(wl + WL_GU1), M, 2 * FF, D}; pg8::StaticOrder S; S.init(M, 2 * FF, F.G, F.bid); pg8::EpiSwiglu E{HB, FF, RSS, D};
            pg8::gemm_phase<pg8::EpiSwiglu, pg8::StaticOrder, true, true>(F.lds, g, S, E, F.tid););
        PHASE(pb + 1, 3, pg8::Gemm g{HB, (const bf16*)(wl + WL_D1), M, D, FF}; pg8::StaticOrder S; S.init(M, D, F.G, F.bid); pg8::EpiResid E{L == 0 ? IN_X : X, X, XB, RSS, D, 0.5f * rs};
            pg8::gemm_phase<pg8::EpiResid, pg8::StaticOrder, true, true>(F.lds, g, S, E, F.tid););
        PHASE(pb + 2, 4, pg8::Gemm g{XB, (const bf16*)(wl + WL_IN), M, LDP, D}; pg8::StaticOrder S; S.init(M, LDP, F.G, F.bid); pg8::EpiStoreBf16 E{PROJ, LDPP, RSS, D};
            pg8::gemm_phase<pg8::EpiStoreBf16, pg8::StaticOrder, true, true>(F.lds, g, S, E, F.tid););
        PHASE(pb + 3, 5, rope_conv_phase(F, PROJ, YMIX, IN_CW + L * 3 * 512););
        PHASE(pb + 4, 6, p6_phase(F, PROJ, YMIX, SCORES, LSE););
        PHASE(pb + 5, 7, p7_phase(F, PROJ, YMIX, SCORES, LSE, extra ? PROBE_P7MODE : 0););
        PHASE(pb + 6, 8, pg8::Gemm g{YMIX, (const bf16*)(wl + WL_OUT), M, D, D}; pg8::StaticOrder S; S.init(M, D, F.G, F.bid); pg8::EpiResid E{X, X, XB, RSS, D, rs};
            pg8::gemm_phase<pg8::EpiResid, pg8::StaticOrder, true, true>(F.lds, g, S, E, F.tid););
        PHASE(pb + 7, 2, pg8::Gemm g{XB, (const bf16*)(wl + WL_GU2), M, 2 * FF, D}; pg8::StaticOrder S; S.init(M, 2 * FF, F.G, F.bid); pg8::EpiSwiglu E{HB, FF, RSS, D};
            pg8::gemm_phase<pg8::EpiSwiglu, pg8::StaticOrder, true, true>(F.lds, g, S, E, F.tid););
        PHASE(pb + 8, 3, pg8::Gemm g{HB, (const bf16*)(wl + WL_D2), M, D, FF}; pg8::StaticOrder S; S.init(M, D, F.G, F.bid); pg8::EpiResid E{X, X, XB, RSS, D, 0.5f * rs};
            pg8::gemm_phase<pg8::EpiResid, pg8::StaticOrder, true, true>(F.lds, g, S, E, F.tid););
    }
    if (PHM(9) && IN(PH_FINAL)) { RELANE(); final_norm_phase(F, X, IN_NF); }
#undef IN
#undef SEAM
}

#ifndef MK_PER_PHASE
#define MK_PER_PHASE 0
#endif
extern "C" void kernel_launch(void* const* d_in, const int* in_sizes, int n_in, void* d_out, int out_size, void* d_ws, size_t ws_size, hipStream_t stream) {
    static int grid = 0;
    if (grid == 0) {
        if (n_in != 15 || out_size != M * D || ws_size < WS_END) { fprintf(stderr, "kernel_launch: unexpected shapes (n_in %d, out %d, ws %zu < %zu); nothing launched\n", n_in, out_size, ws_size, (size_t)WS_END); grid = -1; return; }
        int dev = 0, cus = 0, per_cu = 0;
        if (hipGetDevice(&dev) != hipSuccess || hipDeviceGetAttribute(&cus, hipDeviceAttributeMultiprocessorCount, dev) != hipSuccess) { grid = -1; return; }
        if (hipFuncSetAttribute((const void*)fwd_kernel, hipFuncAttributeMaxDynamicSharedMemorySize, LDS_BYTES) != hipSuccess) { fprintf(stderr, "kernel_launch: hipFuncSetAttribute failed\n"); grid = -1; return; }
        if (hipOccupancyMaxActiveBlocksPerMultiprocessor(&per_cu, (const void*)fwd_kernel, NWAVES * 64, LDS_BYTES) != hipSuccess || per_cu < 1) fprintf(stderr, "kernel_launch: occupancy query says %d\n", per_cu);
        (void)hipGetLastError();
        grid = cus;
    }
    if (grid < 0) return;
    if (hipMemsetAsync((char*)d_ws + WS_CTL, 0, CTL_ZERO_BYTES, stream) != hipSuccess) return;
    Args a{};
    for (int i = 0; i < 15; ++i) a.in[i] = d_in[i];
    a.out = (float*)d_out; a.ws = (unsigned char*)d_ws;
#if MK_PER_PHASE
    for (int p = 0; p < N_PHASES; ++p) { a.ph_lo = p; a.ph_hi = p + 1; hipLaunchKernelGGL(fwd_kernel, dim3(grid), dim3(NWAVES * 64), LDS_BYTES, stream, a); }
#else
    a.ph_lo = 0; a.ph_hi = N_PHASES;
    hipLaunchKernelGGL(fwd_kernel, dim3(grid), dim3(NWAVES * 64), LDS_BYTES, stream, a);
#endif
}
```

```cpp
#include <hip/hip_runtime.h>
#include <cstdio>
#include <cstdint>
namespace pg8 {
#define PG8_LAS __attribute__((address_space(3)))
typedef unsigned short bf16_t;
typedef short bf16x8 __attribute__((ext_vector_type(8)));
typedef float f32x4 __attribute__((ext_vector_type(4)));
typedef unsigned u32x4 __attribute__((ext_vector_type(4)));
constexpr int BM = 256, BK = 64, HALF = 128, HTB = HALF * BK * 2  , STAGE_BYTES = 8 * HTB, NXCD = 8, WGM = 8;

__host__ __device__ __forceinline__ int lds_byte(int r, int c) { const int st = (r >> 4) * 2 + (c >> 5), rr = r & 15, cc = c & 31, ob = rr * 64 + cc * 2; return st * 1024 + (ob ^ (((ob >> 9) & 1) << 5)); }
__host__ __device__ __forceinline__ void stage_rc(int b, int& R, int& C) { const int st = b / 1024, sb = b % 1024, swz = sb ^ (((sb >> 9) & 1) << 5); R = (st >> 1) * 16 + swz / 64; C = (st & 1) * 32 + (swz % 64) / 2; }
__host__ __device__ __forceinline__ int perm32(int rho) { const int n = rho >> 4, i = rho & 15; return 8 * (i >> 2) + 4 * n + (i & 3); }

struct Unit { int pm, pn; };
struct Gemm { const bf16_t* A; const bf16_t* Bt; int M, N, K; };

struct StaticOrder {
    int nM, nN, nwg, G, c;
    __host__ __device__ void init(int M, int N, int G_, int c_) { nM = M / BM; nN = N / BM; nwg = nM * nN; G = G_; c = c_; }
    __host__ __device__ bool next(int i, Unit& u) const {
        const long L = (long)i * G + c; if (L >= nwg) return false;
        int wgid = (int)L; { const int q = nwg / NXCD, r = nwg % NXCD, xcd = wgid % NXCD, off = wgid / NXCD; wgid = (xcd < r ? xcd * (q + 1) : r * (q + 1) + (xcd - r) * q) + off; }
        const int nig = WGM * nN, gid = wgid / nig, fm = gid * WGM, gsz = (nM - fm) < WGM ? (nM - fm) : WGM;
        u.pm = fm + ((wgid % nig) % gsz); u.pn = (wgid % nig) / gsz; return true;
    }
    __device__ __forceinline__ void a_ready(const Unit&) const {}
    __device__ __forceinline__ void done(const Unit&) const {}
};

__device__ __forceinline__ unsigned cvt_pk_bf16(float lo, float hi) { unsigned r; asm volatile("v_cvt_pk_bf16_f32 %0, %1, %2" : "=v"(r) : "v"(lo), "v"(hi)); return r; }
typedef float f32x2 __attribute__((ext_vector_type(2)));
__device__ __forceinline__ void swap16(float& a, float& b) { asm volatile("s_nop 1\n\tv_permlane16_swap_b32 %0, %1" : "+v"(a), "+v"(b)); }
__device__ __forceinline__ void swap32(float& a, float& b) { asm volatile("s_nop 1\n\tv_permlane32_swap_b32 %0, %1" : "+v"(a), "+v"(b)); }
__device__ __forceinline__ float xadd16(float v) { float a = v, b = v; swap16(a, b); return a + b; }
__device__ __forceinline__ float xadd32(float v) { float a = v, b = v; swap32(a, b); return a + b; }
constexpr float RMS_EPS_ = 1e-6f;
__device__ __forceinline__ void row_rsqrt(const float* rss, int row0, int fq, int ncols, float (&rr)[2][4]) {
    f32x4 pa[8], pb[8];
#pragma unroll
    for (int i = 0; i < 8; ++i) { const f32x4* p = (const f32x4*)(rss + (size_t)(row0 + (i >> 2) * HALF + (i & 3) * 16) * 32 + fq * 8); pa[i] = p[0]; pb[i] = p[1]; }
#pragma unroll
    for (int i = 0; i < 8; ++i) { const f32x4 a = pa[i], b = pb[i];
        float s = ((a[0] + a[1]) + (a[2] + a[3])) + ((b[0] + b[1]) + (b[2] + b[3])); s = xadd16(s); s = xadd32(s);
        rr[i >> 2][i & 3] = __builtin_amdgcn_rsqf(s * (1.0f / (float)ncols) + RMS_EPS_); }
}
struct EpiStoreBf16 {
    static constexpr bool PERM = true, AFTER_DRAIN = false;
    bf16_t* O; int ldc; const float* rss; int ncols;
    __device__ __forceinline__ void operator()(const f32x4 (&acc)[2][2][4][2], const Unit& u, int wr, int wc, int fr, int fq) const {
        const int row0 = u.pm * BM + wr * 64 + fr, col0 = u.pn * BM + wc * 32 + 8 * fq;
        float rr[2][4]; row_rsqrt(rss, row0, fq, ncols, rr);
#pragma unroll
        for (int ai = 0; ai < 2; ++ai)
#pragma unroll
            for (int m = 0; m < 4; ++m) { bf16_t* rowp = O + (size_t)(row0 + ai * HALF + m * 16) * ldc + col0; const float r = rr[ai][m];
#pragma unroll
                for (int bj = 0; bj < 2; ++bj) { const f32x4 v0 = acc[ai][bj][m][0] * r, v1 = acc[ai][bj][m][1] * r;
                    u32x4 w; w.x = cvt_pk_bf16(v0[0], v0[1]); w.y = cvt_pk_bf16(v0[2], v0[3]); w.z = cvt_pk_bf16(v1[0], v1[1]); w.w = cvt_pk_bf16(v1[2], v1[3]);
                    *(u32x4*)(rowp + bj * HALF) = w; } }
    }
};
struct EpiSwiglu {
    static constexpr bool PERM = true, AFTER_DRAIN = false;
    bf16_t* H; int ldh; const float* rss; int ncols;
    __device__ __forceinline__ static float silu_mul(float g, float u) { return g * u * __builtin_amdgcn_rcpf(1.0f + __builtin_amdgcn_exp2f(-1.4426950408889634f * g)); }
    __device__ __forceinline__ void operator()(const f32x4 (&acc)[2][2][4][2], const Unit& u, int wr, int wc, int fr, int fq) const {
        const int row0 = u.pm * BM + wr * 64 + fr, col0 = u.pn * HALF + wc * 32 + 8 * fq;
        float rr[2][4]; row_rsqrt(rss, row0, fq, ncols, rr);
#pragma unroll
        for (int ai = 0; ai < 2; ++ai)
#pragma unroll
            for (int m = 0; m < 4; ++m) { bf16_t* rowp = H + (size_t)(row0 + ai * HALF + m * 16) * ldh + col0; const float r = rr[ai][m];
                const f32x4 g0 = acc[ai][0][m][0] * r, g1 = acc[ai][0][m][1] * r, u0 = acc[ai][1][m][0] * r, u1 = acc[ai][1][m][1] * r;
                u32x4 w;
                w.x = cvt_pk_bf16(silu_mul(g0[0], u0[0]), silu_mul(g0[1], u0[1])); w.y = cvt_pk_bf16(silu_mul(g0[2], u0[2]), silu_mul(g0[3], u0[3]));
                w.z = cvt_pk_bf16(silu_mul(g1[0], u1[0]), silu_mul(g1[1], u1[1])); w.w = cvt_pk_bf16(silu_mul(g1[2], u1[2]), silu_mul(g1[3], u1[3]));
                *(u32x4*)rowp = w; }
    }
};
struct EpiResid {
    static constexpr bool PERM = true, AFTER_DRAIN = false;
    const float* src; float* dst; bf16_t* xb; float* rss; int ldc; float scale;
    __device__ __forceinline__ void operator()(const f32x4 (&acc)[2][2][4][2], const Unit& u, int wr, int wc, int fr, int fq) const {
        const int row0 = u.pm * BM + wr * 64 + fr, col0 = u.pn * BM + wc * 32 + 8 * fq;
#pragma unroll
        for (int ai = 0; ai < 2; ++ai)
#pragma unroll
            for (int mp = 0; mp < 2; ++mp) {
                f32x4 b[2][2][2]; float ss[2];
#pragma unroll
                for (int q = 0; q < 2; ++q) { const size_t off = (size_t)(row0 + ai * HALF + (2 * mp + q) * 16) * ldc + col0;
#pragma unroll
                    for (int bj = 0; bj < 2; ++bj) { b[q][bj][0] = *(const f32x4*)(src + off + bj * HALF); b[q][bj][1] = *(const f32x4*)(src + off + bj * HALF + 4); } }
#pragma unroll
                for (int q = 0; q < 2; ++q) { const int m = 2 * mp + q; const size_t off = (size_t)(row0 + ai * HALF + m * 16) * ldc + col0; float s = 0.f;
#pragma unroll
                    for (int bj = 0; bj < 2; ++bj) { const f32x4 v0 = b[q][bj][0] + acc[ai][bj][m][0] * scale, v1 = b[q][bj][1] + acc[ai][bj][m][1] * scale;
                        *(f32x4*)(dst + off + bj * HALF) = v0; *(f32x4*)(dst + off + bj * HALF + 4) = v1;
                        s += ((v0[0] * v0[0] + v0[1] * v0[1]) + (v0[2] * v0[2] + v0[3] * v0[3])) + ((v1[0] * v1[0] + v1[1] * v1[1]) + (v1[2] * v1[2] + v1[3] * v1[3]));
                        u32x4 w; w.x = cvt_pk_bf16(v0[0], v0[1]); w.y = cvt_pk_bf16(v0[2], v0[3]); w.z = cvt_pk_bf16(v1[0], v1[1]); w.w = cvt_pk_bf16(v1[2], v1[3]);
                        *(u32x4*)(xb + off + bj * HALF) = w; }
                    ss[q] = s; }
#pragma unroll
                for (int q = 0; q < 2; ++q) { float s = xadd16(ss[q]); s = xadd32(s);
                    if (fq == 0) rss[(size_t)(row0 + ai * HALF + (2 * mp + q) * 16) * 32 + u.pn * 4 + wc] = s; }
                asm volatile("" ::: "memory"); }
    }
};
template <class Epi, class Sched, bool ALIGN_EPI = false, bool SP2 = false>
__device__ __forceinline__ void gemm_phase(PG8_LAS unsigned char* lds, const Gemm g, const Sched& S, const Epi& E, const int tid_in  ) {
    const int tid = tid_in, wid = __builtin_amdgcn_readfirstlane(tid >> 6), lane = tid & 63, wr = wid >> 2, wc = wid & 3, fr = lane & 15, fq = lane >> 4;
    const int K = g.K, nt = K / BK;
    unsigned voffA[2], voffB[2];
#pragma unroll
    for (int i = 0; i < 2; ++i) { int R, C; stage_rc(tid * 16 + i * 8192, R, C); const int Rb = Epi::PERM ? ((R & ~31) + perm32(R & 31)) : R;
        voffA[i] = (unsigned)(R * K + C) * 2u; voffB[i] = (unsigned)(Rb * K + C) * 2u; }
    const size_t kstep = (size_t)(BK * 2);
    const size_t hstep = (size_t)HALF * K * 2;
    const size_t tstep = 2 * hstep;
    const unsigned ldsw = (unsigned)wid * 1024u;
    const int aoff = lds_byte(wr * 64 + fr, fq * 8), boff = lds_byte(wc * 32 + fr, fq * 8);
#define PG8_SA(b, h) (((b) * 2 + (h)) * HTB)
#define PG8_SB(b, h) ((4 + (b) * 2 + (h)) * HTB)
#define PG8_STAGE(bufoff, gbase, voff) do { _Pragma("unroll") for (int _i = 0; _i < 2; ++_i) \
        __builtin_amdgcn_global_load_lds((const unsigned*)((const char*)(gbase) + (voff)[_i]), (PG8_LAS unsigned*)(lds + (bufoff) + ldsw + _i * 8192), 16, 0, 0); } while (0)
#define PG8_LDA(dst, b, h) do { _Pragma("unroll") for (int m = 0; m < 4; ++m) _Pragma("unroll") for (int k = 0; k < 2; ++k) dst[m][k] = *(const PG8_LAS bf16x8*)(lds + PG8_SA(b, h) + aoff + m * 2048 + k * 1024); } while (0)
#define PG8_LDB(dst, b, h) do { _Pragma("unroll") for (int n = 0; n < 2; ++n) _Pragma("unroll") for (int k = 0; k < 2; ++k) dst[n][k] = *(const PG8_LAS bf16x8*)(lds + PG8_SB(b, h) + boff + n * 2048 + k * 1024); } while (0)
#define PG8_MMA(ai, bj, At, Bt) do { __builtin_amdgcn_s_setprio(1); _Pragma("unroll") for (int m = 0; m < 4; ++m) _Pragma("unroll") for (int n = 0; n < 2; ++n) _Pragma("unroll") for (int k = 0; k < 2; ++k) \
        acc[ai][bj][m][n] = __builtin_amdgcn_mfma_f32_16x16x32_bf16(Bt[n][k], At[m][k], acc[ai][bj][m][n], 0, 0, 0); __builtin_amdgcn_s_setprio(0); } while (0)
#define PG8_WAIT_V(n) asm volatile("s_waitcnt vmcnt(" #n ")" ::: "memory")
#define PG8_WAIT_L(n) asm volatile("s_waitcnt lgkmcnt(" #n ")" ::: "memory")
#define PG8_BAR __builtin_amdgcn_s_barrier()
#define PG8_SCHED __builtin_amdgcn_sched_barrier(0)
    Unit cur, nxt; int ui = 0;
    if (!S.next(0, cur)) return;
    f32x4 acc[2][2][4][2];
#pragma unroll
    for (int a = 0; a < 2; ++a)
#pragma unroll
        for (int b = 0; b < 2; ++b)
#pragma unroll
            for (int m = 0; m < 4; ++m)
#pragma unroll
                for (int n = 0; n < 2; ++n) acc[a][b][m][n] = (f32x4){0.f, 0.f, 0.f, 0.f};
    bf16x8 At[4][2], B0[2][2], B1[2][2];
    const char* cA = (const char*)g.A + (size_t)cur.pm * tstep; const char* cB = (const char*)g.Bt + (size_t)cur.pn * tstep;
    S.a_ready(cur);
    if constexpr (SP2) {
        PG8_STAGE(PG8_SB(0, 0), cB, voffB); PG8_STAGE(PG8_SB(0, 1), cB + hstep, voffB); PG8_STAGE(PG8_SA(0, 0), cA, voffA); PG8_STAGE(PG8_SA(0, 1), cA + hstep, voffA);
        if (wr == 1) PG8_BAR;
        PG8_WAIT_V(2); PG8_BAR;
        PG8_STAGE(PG8_SB(1, 0), cB + kstep, voffB); PG8_STAGE(PG8_SA(1, 0), cA + kstep, voffA); PG8_STAGE(PG8_SB(1, 1), cB + hstep + kstep, voffB);
        PG8_WAIT_V(6); PG8_BAR;
    } else {
        PG8_STAGE(PG8_SB(0, 0), cB, voffB); PG8_STAGE(PG8_SA(0, 0), cA, voffA); PG8_STAGE(PG8_SB(0, 1), cB + hstep, voffB); PG8_STAGE(PG8_SA(0, 1), cA + hstep, voffA);
        if (wr == 1) PG8_BAR;
        PG8_WAIT_V(4); PG8_BAR;
        PG8_STAGE(PG8_SB(1, 0), cB + kstep, voffB); PG8_STAGE(PG8_SA(1, 0), cA + kstep, voffA); PG8_STAGE(PG8_SB(1, 1), cB + hstep + kstep, voffB);
        PG8_WAIT_V(6); PG8_BAR;
    }
    for (;;) {
        const bool has_next = S.next(ui + 1, nxt);
        const char* nA = has_next ? (const char*)g.A + (size_t)nxt.pm * tstep : cA; const char* nB = has_next ? (const char*)g.Bt + (size_t)nxt.pn * tstep : cB;
        for (int t = 0; t < nt; t += 2) {
            const bool last = (t == nt - 2);
            const char* a1 = cA + (size_t)(t + 1) * kstep;
            const char* a2 = last ? nA : cA + (size_t)(t + 2) * kstep; const char* b2 = last ? nB : cB + (size_t)(t + 2) * kstep;
            const char* a3 = a2 + kstep; const char* b3 = b2 + kstep;
            if (last && has_next) S.a_ready(nxt);
            if constexpr (SP2) {
            PG8_LDB(B0, 0, 0); PG8_LDB(B1, 0, 1); PG8_SCHED; PG8_LDA(At, 0, 0); PG8_STAGE(PG8_SA(1, 1), a1 + hstep, voffA);
            PG8_WAIT_V(8); PG8_WAIT_L(0); PG8_BAR; PG8_MMA(0, 0, At, B0); PG8_MMA(0, 1, At, B1); PG8_BAR; PG8_SCHED;
            PG8_LDA(At, 0, 1); PG8_STAGE(PG8_SB(0, 0), b2, voffB); PG8_STAGE(PG8_SB(0, 1), b2 + hstep, voffB); PG8_STAGE(PG8_SA(0, 0), a2, voffA);
            PG8_WAIT_V(8); PG8_WAIT_L(0); PG8_BAR; PG8_MMA(1, 0, At, B0); PG8_MMA(1, 1, At, B1); PG8_BAR; PG8_SCHED;
            PG8_LDB(B0, 1, 0); PG8_LDB(B1, 1, 1); PG8_SCHED; PG8_LDA(At, 1, 0); PG8_STAGE(PG8_SA(0, 1), a2 + hstep, voffA);
            PG8_WAIT_V(8); PG8_WAIT_L(0); PG8_BAR; PG8_MMA(0, 0, At, B0); PG8_MMA(0, 1, At, B1); PG8_BAR; PG8_SCHED;
            PG8_LDA(At, 1, 1); PG8_STAGE(PG8_SB(1, 0), b3, voffB); PG8_STAGE(PG8_SB(1, 1), b3 + hstep, voffB); PG8_STAGE(PG8_SA(1, 0), a3, voffA);
            PG8_WAIT_V(8); PG8_WAIT_L(0); PG8_BAR; PG8_MMA(1, 0, At, B0); PG8_MMA(1, 1, At, B1); PG8_BAR; PG8_SCHED;
            } else {
            PG8_LDB(B0, 0, 0); PG8_SCHED; PG8_LDA(At, 0, 0); PG8_STAGE(PG8_SA(1, 1), a1 + hstep, voffA);
            PG8_WAIT_L(8); PG8_BAR; PG8_WAIT_L(0); PG8_MMA(0, 0, At, B0); PG8_BAR; PG8_SCHED;
            PG8_LDB(B1, 0, 1); PG8_STAGE(PG8_SB(0, 0), b2, voffB);
            PG8_BAR; PG8_WAIT_L(0); PG8_MMA(0, 1, At, B1); PG8_BAR;
            PG8_LDA(At, 0, 1); PG8_STAGE(PG8_SA(0, 0), a2, voffA);
            PG8_BAR; PG8_WAIT_L(0); PG8_MMA(1, 0, At, B0); PG8_BAR; PG8_SCHED;
            PG8_STAGE(PG8_SB(0, 1), b2 + hstep, voffB);
            PG8_WAIT_V(6); PG8_BAR; PG8_MMA(1, 1, At, B1); PG8_BAR;
            PG8_LDB(B0, 1, 0); PG8_SCHED; PG8_LDA(At, 1, 0); PG8_STAGE(PG8_SA(0, 1), a2 + hstep, voffA);
            PG8_WAIT_L(8); PG8_BAR; PG8_WAIT_L(0); PG8_MMA(0, 0, At, B0); PG8_BAR; PG8_SCHED;
            PG8_LDB(B1, 1, 1); PG8_STAGE(PG8_SB(1, 0), b3, voffB);
            PG8_BAR; PG8_WAIT_L(0); PG8_MMA(0, 1, At, B1); PG8_BAR;
            PG8_LDA(At, 1, 1); PG8_STAGE(PG8_SA(1, 0), a3, voffA);
            PG8_BAR; PG8_WAIT_L(0); PG8_MMA(1, 0, At, B0); PG8_BAR; PG8_SCHED;
            PG8_STAGE(PG8_SB(1, 1), b3 + hstep, voffB);
            PG8_WAIT_V(6); PG8_BAR; PG8_MMA(1, 1, At, B1); PG8_BAR;
            }
        }
        if constexpr (ALIGN_EPI) { if (wr == 0) PG8_BAR; }
        if constexpr (!Epi::AFTER_DRAIN) { E(acc, cur, wr, wc, fr, fq); S.done(cur); }
        if (!has_next) break;
#pragma unroll
        for (int a = 0; a < 2; ++a)
#pragma unroll
            for (int b = 0; b < 2; ++b)
#pragma unroll
                for (int m = 0; m < 4; ++m)
#pragma unroll
                    for (int n = 0; n < 2; ++n) acc[a][b][m][n] = (f32x4){0.f, 0.f, 0.f, 0.f};
        cur = nxt; cA = nA; cB = nB; ++ui;
        if constexpr (ALIGN_EPI) { if (wr == 1) PG8_BAR; }
    }
    PG8_WAIT_V(0);
    if constexpr (!ALIGN_EPI) { if (wr == 0) PG8_BAR; }
    PG8_BAR;
    if constexpr (Epi::AFTER_DRAIN) { E.fused(acc, cur, wr, wc, fr, fq, lds, wid, lane); S.done(cur); }
#undef PG8_SA
#undef PG8_SB
#undef PG8_STAGE
#undef PG8_LDA
#undef PG8_LDB
#undef PG8_MMA
#undef PG8_WAIT_V
#undef PG8_WAIT_L
#undef PG8_BAR
#undef PG8_SCHED
}
}
#define LAS __attribute__((address_space(3)))
#define XB_TMO      128
#define XB_XCNT(j)  (256  + 64 * (j))
#define XB_XSUB(j)  (1280 + 64 * (j))
#define XB_XGEN(j)  (2304 + 64 * (j))
#define XB_TOP      3328
#define XB_TOPGEN   3392
#define XCD_BAR_WORDS 3456
#define XB_SPIN_CAP (1u << 18)

__device__ __forceinline__ unsigned xb_ld(unsigned* p)              { return __hip_atomic_load(p, __ATOMIC_RELAXED, __HIP_MEMORY_SCOPE_AGENT); }
__device__ __forceinline__ unsigned xb_add(unsigned* p, unsigned v) { return __hip_atomic_fetch_add(p, v, __ATOMIC_RELAXED, __HIP_MEMORY_SCOPE_AGENT); }
__device__ __forceinline__ unsigned xb_xcc_id() { return (unsigned)__builtin_amdgcn_s_getreg((3 << 11) | 20) & 0xFu; }
#define XB_SPIN(cond, bar) do { unsigned _sp = 0; while (cond) { __builtin_amdgcn_s_sleep(1); \
    if ((++_sp & 255u) == 0u) { if (xb_ld(&(bar)[XB_TMO])) break; if (_sp > XB_SPIN_CAP) { atomicAdd(&(bar)[XB_TMO], 1u); break; } } } } while (0)

struct XcdBarrier {
    unsigned* bar; unsigned x;
    volatile LAS unsigned* st;
};

__device__ __forceinline__ XcdBarrier xcd_barrier_post(unsigned* bar, volatile LAS unsigned* st) {
    XcdBarrier b; b.bar = bar; b.x = xb_xcc_id(); b.st = st;
    if (threadIdx.x == 0) (void)xb_add(&bar[XB_XCNT(b.x)], 1u);
    return b;
}
__device__ __forceinline__ void xcd_barrier_complete(unsigned* bar, unsigned x, unsigned& nloc, unsigned& nx) {
    const unsigned G = gridDim.x * gridDim.y * gridDim.z;
    unsigned sum, cnt, mine, sp = 0u;
    for (;;) {
        sum = 0u; cnt = 0u; mine = 0u;
#pragma unroll
        for (unsigned j = 0; j < 16; ++j) { const unsigned c = xb_ld(&bar[XB_XCNT(j)]); sum += c; cnt += (c > 0u) ? 1u : 0u; mine = (j == x) ? c : mine; }
        if (sum == G) break;
        __builtin_amdgcn_s_sleep(1);
        if ((++sp & 255u) == 0u) { if (xb_ld(&bar[XB_TMO])) break; if (sp > XB_SPIN_CAP) { atomicAdd(&bar[XB_TMO], 1u); break; } }
    }
    nloc = mine > 0u ? mine : 1u; nx = cnt > 0u ? cnt : 1u;
}

__device__ __forceinline__ void xcd_barrier(const XcdBarrier& b) {
    asm volatile("s_waitcnt vmcnt(0)" ::: "memory");
    __syncthreads();
    if (threadIdx.x == 0) {
        unsigned* bar = b.bar;
        __builtin_amdgcn_s_waitcnt(0);
        unsigned nloc = b.st[0], nx = b.st[1];
        if (nloc == 0u) { xcd_barrier_complete(bar, b.x, nloc, nx); b.st[0] = nloc; b.st[1] = nx; }
        const unsigned old = xb_add(&bar[XB_XSUB(b.x)], 1u);
        const unsigned gen = old / nloc;
        if (old + 1u == (gen + 1u) * nloc) {
            __builtin_amdgcn_fence(__ATOMIC_RELEASE, "agent");
            asm volatile("s_waitcnt vmcnt(0)" ::: "memory");
            const unsigned og = xb_add(&bar[XB_TOP], 1u);
            const unsigned tg = og / nx;
            if (og + 1u == (tg + 1u) * nx) xb_add(&bar[XB_TOPGEN], 1u);
            else XB_SPIN(xb_ld(&bar[XB_TOPGEN]) == tg, bar);
            __builtin_amdgcn_fence(__ATOMIC_ACQUIRE, "agent");
            xb_add(&bar[XB_XGEN(b.x)], 1u);
            asm volatile("s_waitcnt vmcnt(0)" ::: "memory");
        } else {
            XB_SPIN(xb_ld(&bar[XB_XGEN(b.x)]) == gen, bar);
            __builtin_amdgcn_fence(__ATOMIC_ACQUIRE, "agent");
            asm volatile("s_waitcnt vmcnt(0)" ::: "memory");
        }
    }
    __syncthreads();
}
constexpr int BATCH = 2, SEQ = 4096, M = BATCH * SEQ, D = 2048, FF = 5632, DEPTH = 4, DIN = 5968, LDP = 6144, LDPP = 6208;
constexpr int NWAVES = 8;
constexpr int P_H = 0, P_GB = 512, P_GC = 1024, P_QB = 1536, P_KB = 2304, P_VB = 2432, P_QI = 2560, P_KI = 3584, P_QC = 3648, P_KC = 4416, P_VC = 5184, P_WI = 5952;
constexpr int Y_A = 0, Y_B = 512, Y_C = 1280;
constexpr float RMS_EPS = 1e-6f;
constexpr float SM_C = 0.08838834764831845f * 1.4426950408889634f;

constexpr size_t MiB = 1u << 20;
constexpr size_t WS_CTL = 0, CTL_ZERO_BYTES = 1 * MiB;
constexpr size_t WS_COSH = 1 * MiB, WS_SINH = 3 * MiB, WS_COSI = 5 * MiB, WS_SINI = 6 * MiB, WS_LSE = 7 * MiB, WS_RSS = 257 * MiB;
constexpr size_t WS_XN = 8 * MiB, WS_YMIX = 40 * MiB, WS_H = 72 * MiB, WS_PROJ = 160 * MiB, WS_SCORES = 258 * MiB, WS_W = 386 * MiB;
constexpr size_t WL_GU1 = 0, WL_D1 = 44 * MiB, WL_IN = 66 * MiB, WL_OUT = 90 * MiB, WL_GU2 = 98 * MiB, WL_D2 = 142 * MiB, WL_STRIDE = 164 * MiB;
constexpr size_t WS_KV = WS_W + DEPTH * WL_STRIDE, WS_KI = WS_KV + 4 * MiB, WS_END = WS_KI + 1 * MiB;
static_assert((size_t)M * FF * 2 <= WS_PROJ - WS_H && (size_t)M * LDPP * 2 <= WS_RSS - WS_PROJ && WS_RSS + (size_t)M * 32 * 4 <= WS_SCORES && (size_t)M * SEQ * 4 <= WS_W - WS_SCORES, "ws map");
static_assert((size_t)2 * FF * D * 2 <= WL_D1 && (size_t)D * FF * 2 <= WL_IN - WL_D1 && (size_t)LDP * D * 2 <= WL_OUT - WL_IN && (size_t)D * D * 2 <= WL_GU2 - WL_OUT, "weight map");
constexpr int CW_BAR = 4096;

constexpr int RING_BYTES = 131072, MISC_OFF = RING_BYTES + 320, LDS_BYTES = 147456;

typedef unsigned short bf16;
typedef unsigned v4u __attribute__((ext_vector_type(4)));
typedef unsigned v2u __attribute__((ext_vector_type(2)));
typedef float f32x4 __attribute__((ext_vector_type(4)));
typedef float f32x16 __attribute__((ext_vector_type(16)));
typedef short bf16x8 __attribute__((ext_vector_type(8)));
typedef short s16x4 __attribute__((ext_vector_type(4)));

__device__ __forceinline__ unsigned f2bf(float f) { unsigned u = __builtin_bit_cast(unsigned, f); return (u + 0x7fffu + ((u >> 16) & 1u)) >> 16; }
__device__ __forceinline__ unsigned pk2(float lo, float hi) { return f2bf(lo) | (f2bf(hi) << 16); }
__device__ __forceinline__ float bf_lo(unsigned w) { return __builtin_bit_cast(float, w << 16); }
__device__ __forceinline__ float bf_hi(unsigned w) { return __builtin_bit_cast(float, w & 0xffff0000u); }
__device__ __forceinline__ float bf2f(bf16 b) { return __builtin_bit_cast(float, (unsigned)b << 16); }
__device__ __forceinline__ float wave_sum(float v) {
#pragma unroll
    for (int o = 1; o < 64; o <<= 1) v += __shfl_xor(v, o);
    return v;
}

__device__ const float INV_H[64] = {
1.000000000e+00f, 8.659643531e-01f, 7.498942018e-01f, 6.493816376e-01f, 5.623413324e-01f, 4.869675338e-01f, 4.216965139e-01f, 3.651741147e-01f, 3.162277639e-01f, 2.738419771e-01f, 2.371373922e-01f, 2.053525001e-01f, 1.778279394e-01f, 1.539926529e-01f, 1.333521456e-01f, 1.154782027e-01f, 1.000000015e-01f, 8.659642935e-02f, 7.498941571e-02f, 6.493816525e-02f, 5.623412877e-02f, 4.869675264e-02f, 4.216964915e-02f, 3.651741147e-02f, 3.162277862e-02f, 2.738419734e-02f, 2.371373586e-02f, 2.053524926e-02f, 1.778279431e-02f, 1.539926510e-02f, 1.333521493e-02f, 1.154781971e-02f, 9.999999776e-03f, 8.659643121e-03f, 7.498942316e-03f, 6.493816618e-03f, 5.623413250e-03f, 4.869675264e-03f, 4.216964822e-03f, 3.651741426e-03f, 3.162277862e-03f, 2.738419687e-03f, 2.371373819e-03f, 2.053525066e-03f, 1.778279431e-03f, 1.539926627e-03f, 1.333521446e-03f, 1.154781901e-03f, 1.000000047e-03f, 8.659643354e-04f, 7.498941850e-04f, 6.493816618e-04f, 5.623413017e-04f, 4.869675031e-04f, 4.216965463e-04f, 3.651741135e-04f, 3.162277862e-04f, 2.738419571e-04f, 2.371373848e-04f, 2.053525241e-04f, 1.778279402e-04f, 1.539926452e-04f, 1.333521504e-04f, 1.154782076e-04f };

struct Frame {
    LAS unsigned char* lds;
    int tid, lane, wave, bid, G, gw, NGW;
    unsigned char* ws;
};

template <int MODE> __device__ __forceinline__ int rowmap(int n) {
    if (MODE == 1) return 256 * (n >> 7) + (n & 127);
    if (MODE == 2) return 256 * (n >> 7) + 128 + (n & 127);
    if (MODE == 3) return n < 3648 ? n : (n < 3664 ? P_WI + (n - 3648) : n - 16);
    return n;
}
template <int MODE> __device__ __forceinline__ void transpose_item(const float* W, int K, int N, bf16* WT, LAS float* scr, int item, int lane, const float* gain  ) {
    const int nblk = (N + 31) / 32, kb = item / nblk, nb = item % nblk, k0 = 64 * kb, n0 = 32 * nb;
    const int nn = n0 + (lane & 31); const bool nok = nn < N;
    const int c = lane & 7;
    float gv[8];
    if (gain) { const f32x4 g0 = *(const f32x4*)(gain + k0 + 8 * c), g1 = *(const f32x4*)(gain + k0 + 8 * c + 4); gv[0] = g0[0]; gv[1] = g0[1]; gv[2] = g0[2]; gv[3] = g0[3]; gv[4] = g1[0]; gv[5] = g1[1]; gv[6] = g1[2]; gv[7] = g1[3]; }
    else {
#pragma unroll
        for (int e = 0; e < 8; ++e) gv[e] = 1.0f; }
    float wv_[32];
#pragma unroll
    for (int i = 0; i < 32; ++i) wv_[i] = W[(size_t)(k0 + 2 * i + (lane >> 5)) * N + (nok ? nn : n0)];
#pragma unroll
    for (int i = 0; i < 32; ++i) scr[(2 * i + (lane >> 5)) * 33 + (lane & 31)] = nok ? wv_[i] : 0.f;
    asm volatile("s_waitcnt lgkmcnt(0)" ::: "memory");
#pragma unroll
    for (int j = 0; j < 4; ++j) { const int n = (lane >> 3) + 8 * j; const LAS float* s = scr + (8 * c) * 33 + n;
        v4u o; o.x = pk2(s[0 * 33] * gv[0], s[1 * 33] * gv[1]); o.y = pk2(s[2 * 33] * gv[2], s[3 * 33] * gv[3]); o.z = pk2(s[4 * 33] * gv[4], s[5 * 33] * gv[5]); o.w = pk2(s[6 * 33] * gv[6], s[7 * 33] * gv[7]);
        if (n0 + n < N) *(v4u*)(WT + (size_t)rowmap<MODE>(n0 + n) * K + k0 + 8 * c) = o; }
    asm volatile("s_waitcnt lgkmcnt(0)" ::: "memory");
}
__device__ __forceinline__ void sincos_d(double a, float& sn, float& cs) {
    const double k = __builtin_rint(a * 0.63661977236758134308);
    double r = __builtin_fma(-k, 1.57079632679489655800e+00, a); r = __builtin_fma(-k, 6.12323399573676603587e-17, r);
    const int q = (int)((long long)k & 3);
    const double r2 = r * r;
    double s = -1.0 / 39916800.0; s = s * r2 + 1.0 / 362880.0; s = s * r2 - 1.0 / 5040.0; s = s * r2 + 1.0 / 120.0; s = s * r2 - 1.0 / 6.0; s = s * r2 * r + r;
    double c = 1.0 / 479001600.0; c = c * r2 - 1.0 / 3628800.0; c = c * r2 + 1.0 / 40320.0; c = c * r2 - 1.0 / 720.0; c = c * r2 + 1.0 / 24.0; c = c * r2 - 0.5; c = c * r2 + 1.0;
    const double ss = (q & 1) ? c : s, cc = (q & 1) ? s : c;
    sn = (float)((q & 2) ? -ss : ss); cs = (float)(((q + 1) & 2) ? -cc : cc);
}
struct Args { const void* in[15]; float* out; unsigned char* ws; int ph_lo, ph_hi; };
#define IN_X ((const float*)args.in[0])
#define IN_POS ((const int*)args.in[1])
#define IN_N1 ((const float*)args.in[2])
#define IN_G1 ((const float*)args.in[3])
#define IN_U1 ((const float*)args.in[4])
#define IN_D1 ((const float*)args.in[5])
#define IN_NM ((const float*)args.in[6])
#define IN_WIN ((const float*)args.in[7])
#define IN_CW ((const float*)args.in[8])
#define IN_WOUT ((const float*)args.in[9])
#define IN_N2 ((const float*)args.in[10])
#define IN_G2 ((const float*)args.in[11])
#define IN_U2 ((const float*)args.in[12])
#define IN_D2 ((const float*)args.in[13])
#define IN_NF ((const float*)args.in[14])
__device__ __forceinline__ void prologue(Frame& F, const Args& args) {
    LAS float* scr = (LAS float*)(F.lds + F.wave * 16384);
    constexpr int I_G = (D / 64) * (FF / 32), I_D = (FF / 64) * (D / 32), I_IN = (D / 64) * ((DIN + 31) / 32), I_OUT = (D / 64) * (D / 32);
    constexpr int PER_LAYER = 4 * I_G + 2 * I_D + I_IN + I_OUT;
    for (int it = F.gw; it < DEPTH * PER_LAYER; it += F.NGW) {
        const int L = it / PER_LAYER; int r = it % PER_LAYER;
        unsigned char* wl = F.ws + WS_W + (size_t)L * WL_STRIDE;
        const size_t og = (size_t)L * D * FF, oin = (size_t)L * D * DIN, oout = (size_t)L * D * D;
        if (r < I_G) { transpose_item<1>(IN_G1 + og, D, FF, (bf16*)(wl + WL_GU1), scr, r, F.lane, IN_N1 + L * D); continue; } r -= I_G;
        if (r < I_G) { transpose_item<2>(IN_U1 + og, D, FF, (bf16*)(wl + WL_GU1), scr, r, F.lane, IN_N1 + L * D); continue; } r -= I_G;
        if (r < I_D) { transpose_item<0>(IN_D1 + og, FF, D, (bf16*)(wl + WL_D1), scr, r, F.lane, nullptr); continue; } r -= I_D;
        if (r < I_G) { transpose_item<1>(IN_G2 + og, D, FF, (bf16*)(wl + WL_GU2), scr, r, F.lane, IN_N2 + L * D); continue; } r -= I_G;
        if (r < I_G) { transpose_item<2>(IN_U2 + og, D, FF, (bf16*)(wl + WL_GU2), scr, r, F.lane, IN_N2 + L * D); continue; } r -= I_G;
        if (r < I_D) { transpose_item<0>(IN_D2 + og, FF, D, (bf16*)(wl + WL_D2), scr, r, F.lane, nullptr); continue; } r -= I_D;
        if (r < I_IN) { transpose_item<3>(IN_WIN + oin, D, DIN, (bf16*)(wl + WL_IN), scr, r, F.lane, IN_NM + L * D); continue; } r -= I_IN;
        transpose_item<0>(IN_WOUT + oout, D, D, (bf16*)(wl + WL_OUT), scr, r, F.lane, nullptr);
    }
    for (int L = 0; L < DEPTH; ++L) { v4u* p = (v4u*)(F.ws + WS_W + (size_t)L * WL_STRIDE + WL_IN + (size_t)DIN * D * 2);
        for (int i = F.gw * 64 + F.lane; i < (LDP - DIN) * D * 2 / 16; i += F.NGW * 64) p[i] = (v4u){0u, 0u, 0u, 0u}; }
    { bf16* xb = (bf16*)(F.ws + WS_XN); float* rss = (float*)(F.ws + WS_RSS);
      for (int m = F.gw; m < M; m += F.NGW) { const f32x4* xr = (const f32x4*)(IN_X + (size_t)m * D) + F.lane; v2u* o = (v2u*)(xb + (size_t)m * D) + F.lane; float s = 0.f;
#pragma unroll
          for (int j = 0; j < 8; ++j) { const f32x4 v = xr[64 * j]; s += (v.x * v.x + v.y * v.y) + (v.z * v.z + v.w * v.w); v2u w; w.x = pk2(v.x, v.y); w.y = pk2(v.z, v.w); o[64 * j] = w; }
          s = wave_sum(s);
          if (F.lane < 32) rss[(size_t)m * 32 + F.lane] = F.lane == 0 ? s : 0.f; } }
    float* cosh_ = (float*)(F.ws + WS_COSH); float* sinh_ = (float*)(F.ws + WS_SINH); float* cosi_ = (float*)(F.ws + WS_COSI); float* sini_ = (float*)(F.ws + WS_SINI);
    for (int m = F.gw; m < M; m += F.NGW) { const float p = (float)IN_POS[m];
        { const float a = p * INV_H[F.lane]; float s, c; sincos_d((double)a, s, c); cosh_[m * 64 + F.lane] = c; sinh_[m * 64 + F.lane] = s; }
        if (F.lane < 32) { const float a = p * INV_H[2 * F.lane]; float s, c; sincos_d((double)a, s, c); cosi_[m * 32 + F.lane] = c; sini_[m * 32 + F.lane] = s; } }
}

__device__ __forceinline__ void norm_phase(Frame& F, const float* x, const float* g, bf16* xn) {
    for (int m = F.gw; m < M; m += F.NGW) {
        const f32x4* xr = (const f32x4*)(x + (size_t)m * D) + F.lane; f32x4 v[8]; float s = 0.f;
#pragma unroll
        for (int j = 0; j < 8; ++j) { v[j] = xr[64 * j]; s += (v[j].x * v[j].x + v[j].y * v[j].y) + (v[j].z * v[j].z + v[j].w * v[j].w); }
        const float r = 1.0f / sqrtf(wave_sum(s) * (1.0f / D) + RMS_EPS);
        v2u* o = (v2u*)(xn + (size_t)m * D) + F.lane;
#pragma unroll
        for (int j = 0; j < 8; ++j) { const f32x4 gg = ((const f32x4*)g)[F.lane + 64 * j]; v2u w; w.x = pk2(v[j].x * r * gg.x, v[j].y * r * gg.y); w.y = pk2(v[j].z * r * gg.z, v[j].w * r * gg.w); o[64 * j] = w; }
    }
}
__device__ __forceinline__ void final_norm_phase(Frame& F, float* x, const float* g) {
    for (int m = F.gw; m < M; m += F.NGW) {
        f32x4* xr = (f32x4*)(x + (size_t)m * D) + F.lane; f32x4 v[8]; float s = 0.f;
#pragma unroll
        for (int j = 0; j < 8; ++j) { v[j] = xr[64 * j]; s += (v[j].x * v[j].x + v[j].y * v[j].y) + (v[j].z * v[j].z + v[j].w * v[j].w); }
        const float r = 1.0f / sqrtf(wave_sum(s) * (1.0f / D) + RMS_EPS);
#pragma unroll
        for (int j = 0; j < 8; ++j) { const f32x4 gg = ((const f32x4*)g)[F.lane + 64 * j]; xr[64 * j] = v[j] * r * gg; }
    }
}

__device__ __forceinline__ void unpack8(const v4u w, float (&f)[8]) { f[0] = bf_lo(w.x); f[1] = bf_hi(w.x); f[2] = bf_lo(w.y); f[3] = bf_hi(w.y); f[4] = bf_lo(w.z); f[5] = bf_hi(w.z); f[6] = bf_lo(w.w); f[7] = bf_hi(w.w); }
__device__ __forceinline__ v4u pack8(const float (&f)[8]) { v4u w; w.x = pk2(f[0], f[1]); w.y = pk2(f[2], f[3]); w.z = pk2(f[4], f[5]); w.w = pk2(f[6], f[7]); return w; }
__device__ __forceinline__ void rope8(const bf16* p1, const bf16* p2, bf16* q1, bf16* q2, const float (&c)[8], const float (&s)[8], float sc) {
    float a[8], b[8], o1[8], o2[8]; unpack8(*(const v4u*)p1, a); unpack8(*(const v4u*)p2, b);
#pragma unroll
    for (int j = 0; j < 8; ++j) { o1[j] = (a[j] * c[j] - b[j] * s[j]) * sc; o2[j] = (b[j] * c[j] + a[j] * s[j]) * sc; }
    *(v4u*)q1 = pack8(o1); *(v4u*)q2 = pack8(o2);
}
__device__ __forceinline__ void rope_conv_phase(Frame& F, bf16* proj, bf16* ymix, const float* convw  ) {
    const float* cosh_ = (const float*)(F.ws + WS_COSH); const float* sinh_ = (const float*)(F.ws + WS_SINH); const float* cosi_ = (const float*)(F.ws + WS_COSI); const float* sini_ = (const float*)(F.ws + WS_SINI);
    const int lane = F.lane; bf16* kvc = (bf16*)(F.ws + WS_KV); bf16* kic = (bf16*)(F.ws + WS_KI);
    float cw0[8], cw1[8], cw2[8];
#pragma unroll
    for (int j = 0; j < 8; ++j) { cw0[j] = convw[8 * lane + j]; cw1[j] = convw[512 + 8 * lane + j]; cw2[j] = convw[1024 + 8 * lane + j]; }
    for (int m = F.gw; m < M; m += F.NGW) {
        bf16* row = proj + (size_t)m * LDPP;
        { const int d8 = 8 * (lane & 7), hs = lane >> 3; float c[8], s[8];
          { const f32x4 c0 = *(const f32x4*)(cosh_ + m * 64 + d8), c1 = *(const f32x4*)(cosh_ + m * 64 + d8 + 4), s0 = *(const f32x4*)(sinh_ + m * 64 + d8), s1 = *(const f32x4*)(sinh_ + m * 64 + d8 + 4);
#pragma unroll
            for (int j = 0; j < 4; ++j) { c[j] = c0[j]; c[4 + j] = c1[j]; s[j] = s0[j]; s[4 + j] = s1[j]; } }
#pragma unroll
          for (int ps = 0; ps < 3; ++ps) { const int hd = ps * 8 + hs;
              if (hd < 19) { const int base = hd < 6 ? P_QB + hd * 128 : (hd == 6 ? P_KB : (hd < 13 ? P_QC + (hd - 7) * 128 : P_KC + (hd - 13) * 128));
                  bf16* dst = hd == 6 ? kvc + (size_t)m * 256 - base : row;
                  rope8(row + base + d8, row + base + 64 + d8, dst + base + d8, dst + base + 64 + d8, c, s, 1.0f); } }
          if (lane < 16) *(v4u*)(kvc + (size_t)m * 256 + 128 + 8 * lane) = *(const v4u*)(row + P_VB + 8 * lane); }
        { const int d8 = 8 * (lane & 3), hd = lane >> 2; float c[8], s[8];
          { const f32x4 c0 = *(const f32x4*)(cosi_ + m * 32 + d8), c1 = *(const f32x4*)(cosi_ + m * 32 + d8 + 4), s0 = *(const f32x4*)(sini_ + m * 32 + d8), s1 = *(const f32x4*)(sini_ + m * 32 + d8 + 4);
#pragma unroll
            for (int j = 0; j < 4; ++j) { c[j] = c0[j]; c[4 + j] = c1[j]; s[j] = s0[j]; s[4 + j] = s1[j]; } }
          rope8(row + P_QI + hd * 64 + d8, row + P_QI + hd * 64 + 32 + d8, row + P_QI + hd * 64 + d8, row + P_QI + hd * 64 + 32 + d8, c, s, 0.125f);
          if (lane < 4) rope8(row + P_KI + d8, row + P_KI + 32 + d8, kic + (size_t)m * 64 + d8, kic + (size_t)m * 64 + 32 + d8, c, s, 1.0f); }
        { const int t = m & (SEQ - 1), ch = 8 * lane; float h0[8], g0[8], h1[8], g1[8], h2[8], g2[8], gb[8], y[8];
          unpack8(*(const v4u*)(row + P_H + ch), h0); unpack8(*(const v4u*)(row + P_GC + ch), g0); unpack8(*(const v4u*)(row + P_GB + ch), gb);
          if (t >= 1) { unpack8(*(const v4u*)(row - LDPP + P_H + ch), h1); unpack8(*(const v4u*)(row - LDPP + P_GC + ch), g1); } else {
#pragma unroll
              for (int j = 0; j < 8; ++j) { h1[j] = 0.f; g1[j] = 0.f; } }
          if (t >= 2) { unpack8(*(const v4u*)(row - 2 * LDPP + P_H + ch), h2); unpack8(*(const v4u*)(row - 2 * LDPP + P_GC + ch), g2); } else {
#pragma unroll
              for (int j = 0; j < 8; ++j) { h2[j] = 0.f; g2[j] = 0.f; } }
#pragma unroll
          for (int j = 0; j < 8; ++j) y[j] = gb[j] * (cw0[j] * (g2[j] * h2[j]) + cw1[j] * (g1[j] * h1[j]) + cw2[j] * (g0[j] * h0[j]));
          *(v4u*)(ymix + (size_t)m * D + Y_A + ch) = pack8(y); }
    }
}

__device__ __forceinline__ int crow(int r, int hi) { return (r & 3) + 8 * (r >> 2) + 4 * hi; }
constexpr int VROW = 320;
constexpr int VTILE = 32 * VROW;
struct AttnSt { f32x16 o[4]; float m, l; };
__device__ __forceinline__ void attn_init(AttnSt& st) {
#pragma unroll
    for (int d = 0; d < 4; ++d)
#pragma unroll
        for (int r = 0; r < 16; ++r) st.o[d][r] = 0.f;
    st.m = -1e30f; st.l = 0.f;
}
__device__ __forceinline__ s16x4 vtr(const LAS unsigned char* p) { return __builtin_bit_cast(s16x4, __builtin_amdgcn_ds_read_tr16_b64_v4i16((LAS s16x4*)p)); }
__device__ __forceinline__ void attn_tile(AttnSt& st, const bf16x8 (&qf)[8], const bf16* kp, const bf16* vp, LAS unsigned char* vl, unsigned vmask, int lane) {
    const int r32 = lane & 31, hi = lane >> 5;
    bf16x8 kf[8], vv[4];
#pragma unroll
    for (int ks = 0; ks < 8; ++ks) kf[ks] = *(const bf16x8*)(kp + ks * 16);
#pragma unroll
    for (int i = 0; i < 4; ++i) vv[i] = *(const bf16x8*)(vp + i * 16);
    f32x16 s;
#pragma unroll
    for (int r = 0; r < 16; ++r) s[r] = 0.f;
#pragma unroll
    for (int ks = 0; ks < 8; ++ks) s = __builtin_amdgcn_mfma_f32_32x32x16_bf16(kf[ks], qf[ks], s, 0, 0, 0);
#pragma unroll
    for (int i = 0; i < 4; ++i) *(LAS bf16x8*)(vl + r32 * VROW + (hi + 2 * i) * 16) = vv[i];
    asm volatile("" ::: "memory");
#pragma unroll
    for (int i = 0; i < 4; ++i) vv[i] = *(const bf16x8*)(vp + (i + 4) * 16);
#pragma unroll
    for (int i = 0; i < 4; ++i) *(LAS bf16x8*)(vl + r32 * VROW + (hi + 2 * (i + 4)) * 16) = vv[i];
    __builtin_amdgcn_sched_barrier(0);
    float mx = -INFINITY;
#pragma unroll
    for (int r = 0; r < 16; ++r) { s[r] = ((vmask >> r) & 1u) ? s[r] : -INFINITY; mx = fmaxf(mx, s[r]); }
    mx = fmaxf(mx, __shfl_xor(mx, 32));
    const float mn = fmaxf(st.m, mx), alpha = __builtin_amdgcn_exp2f((st.m - mn) * SM_C), mc = -mn * SM_C;
    st.m = mn;
    float ps = 0.f;
#pragma unroll
    for (int r = 0; r < 16; ++r) { s[r] = __builtin_amdgcn_exp2f(fmaf(s[r], SM_C, mc)); ps += s[r]; }
    st.l = st.l * alpha + ps;
#pragma unroll
    for (int d = 0; d < 4; ++d) st.o[d] = st.o[d] * alpha;
    bf16x8 pf[2];
#pragma unroll
    for (int sx = 0; sx < 2; ++sx) { v4u w; w.x = pk2(s[8 * sx + 0], s[8 * sx + 1]); w.y = pk2(s[8 * sx + 2], s[8 * sx + 3]); w.z = pk2(s[8 * sx + 4], s[8 * sx + 5]); w.w = pk2(s[8 * sx + 6], s[8 * sx + 7]); pf[sx] = __builtin_bit_cast(bf16x8, w); }
    __builtin_amdgcn_sched_barrier(0);
    const int g4 = lane >> 4, qq = (lane >> 2) & 3, pp = lane & 3;
    const LAS unsigned char* vb = vl + (4 * (g4 >> 1) + qq) * VROW + (16 * (g4 & 1) + 4 * pp) * 2;
#pragma unroll
    for (int d = 0; d < 4; ++d)
#pragma unroll
        for (int sx = 0; sx < 2; ++sx) { const s16x4 lo = vtr(vb + (16 * sx) * VROW + 64 * d), h8 = vtr(vb + (16 * sx + 8) * VROW + 64 * d);
            const bf16x8 a = (bf16x8){lo[0], lo[1], lo[2], lo[3], h8[0], h8[1], h8[2], h8[3]};
            st.o[d] = __builtin_amdgcn_mfma_f32_32x32x16_bf16(a, pf[sx], st.o[d], 0, 0, 0); if (sx == 1) __builtin_amdgcn_sched_barrier(0); }
}

constexpr int KIROW = 144;
__device__ __forceinline__ void indexer_unit(Frame& F, const bf16* proj, float* scores, int b, int tt, int kc) {
    const int lane = F.lane, r32 = lane & 31, hi = lane >> 5;
    const int t0 = tt * 64 + F.wave * 8;
    LAS unsigned char* kl = F.lds + NWAVES * VTILE;
    v4u st[4];
    { const bf16* kib = (const bf16*)(F.ws + WS_KI) + (size_t)(b * SEQ + kc * 256) * 64;
#pragma unroll
      for (int i = 0; i < 4; ++i) st[i] = *(const v4u*)(kib + (size_t)((F.tid >> 3) + 64 * i) * 64 + 8 * (F.tid & 7)); }
    bf16x8 qa[4][4]; float wv[4][16];
    { const int tsel = (r32 >> 2) & 1, head = 4 * (r32 >> 3) + (r32 & 3);
#pragma unroll
      for (int a = 0; a < 4; ++a) { const bf16* qp = proj + (size_t)(b * SEQ + t0 + 2 * a + tsel) * LDPP + P_QI + head * 64 + hi * 8;
#pragma unroll
          for (int ks = 0; ks < 4; ++ks) qa[a][ks] = *(const bf16x8*)(qp + ks * 16);
          const v4u* wp = (const v4u*)(proj + (size_t)(b * SEQ + t0 + 2 * a + hi) * LDPP + P_WI); const v4u w0 = wp[0], w1 = wp[1];
          const unsigned ww[8] = {w0.x, w0.y, w0.z, w0.w, w1.x, w1.y, w1.z, w1.w};
#pragma unroll
          for (int j = 0; j < 8; ++j) { wv[a][2 * j] = 0.25f * bf_lo(ww[j]); wv[a][2 * j + 1] = 0.25f * bf_hi(ww[j]); } } }
    __syncthreads();
#pragma unroll
    for (int i = 0; i < 4; ++i) *(LAS v4u*)(kl + ((F.tid >> 3) + 64 * i) * KIROW + (F.tid & 7) * 16) = st[i];
    __syncthreads();
    for (int kt = 0; kt < 8; ++kt) {
        const int k0 = kc * 256 + kt * 32;
        const LAS unsigned char* kp = kl + (kt * 32 + r32) * KIROW + hi * 16;
        bf16x8 kf[4];
#pragma unroll
        for (int ks = 0; ks < 4; ++ks) kf[ks] = *(const LAS bf16x8*)(kp + ks * 32);
#pragma unroll
        for (int a = 0; a < 4; ++a) { f32x16 acc;
#pragma unroll
            for (int r = 0; r < 16; ++r) acc[r] = 0.f;
#pragma unroll
            for (int ks = 0; ks < 4; ++ks) acc = __builtin_amdgcn_mfma_f32_32x32x16_bf16(qa[a][ks], kf[ks], acc, 0, 0, 0);
            float sc = 0.f;
#pragma unroll
            for (int r = 0; r < 16; ++r) sc = fmaf(wv[a][r], fmaxf(acc[r], 0.f), sc);
            scores[(size_t)(b * SEQ + t0 + 2 * a + hi) * SEQ + k0 + r32] = sc; }
    }
}
__device__ __forceinline__ void dilated_unit(Frame& F, const bf16* proj, bf16* ymix, float* lse, int wu) {
    const int lane = F.lane, r32 = lane & 31, hi = lane >> 5;
    const int b = wu / 768; int rem = wu % 768; const int g = rem >> 8; rem &= 255; const int hh = rem >> 7, ti = rem & 127;
    const int sh = 2 * g, dl = 1 << sh, tpc = 128 >> sh;
    const int r = ti / tpc, i0 = (ti % tpc) * 32, hd = g * 2 + hh;
    LAS unsigned char* vl = F.lds + F.wave * VTILE;
    const int tq = r + dl * (i0 + r32);
    bf16x8 qf[8];
    { const bf16* qp = proj + (size_t)(b * SEQ + tq) * LDPP + P_QC + hd * 128 + hi * 8;
#pragma unroll
      for (int ks = 0; ks < 8; ++ks) qf[ks] = *(const bf16x8*)(qp + ks * 16); }
    AttnSt st; attn_init(st);
    for (int kt = 0; kt < 5; ++kt) {
        const int ib = i0 - 128 + 32 * kt;
        if (ib + 31 < 0) continue;
        const int ik = ib + r32, ikc = ik < 0 ? 0 : ik;
        const bf16* rowp = proj + (size_t)(b * SEQ + r + dl * ikc) * LDPP + hd * 128 + hi * 8;
        unsigned vmask = 0u; const int iq = i0 + r32;
#pragma unroll
        for (int rr = 0; rr < 16; ++rr) { const int ikey = ib + crow(rr, hi); vmask |= (ikey >= 0 && ikey <= iq && ikey >= iq - 128) ? (1u << rr) : 0u; }
        attn_tile(st, qf, rowp + P_KC, rowp + P_VC, vl, vmask, lane);
    }
    const float lt = st.l + __shfl_xor(st.l, 32), inv = 1.0f / lt;
    bf16* op = ymix + (size_t)(b * SEQ + tq) * D + Y_C + hd * 128;
#pragma unroll
    for (int d = 0; d < 4; ++d)
#pragma unroll
        for (int r4 = 0; r4 < 4; ++r4) { v2u w; w.x = pk2(st.o[d][4 * r4] * inv, st.o[d][4 * r4 + 1] * inv); w.y = pk2(st.o[d][4 * r4 + 2] * inv, st.o[d][4 * r4 + 3] * inv);
            *(v2u*)(op + 32 * d + 8 * r4 + 4 * hi) = w; }
    if (hi == 0) lse[(size_t)(b * SEQ + tq) * 6 + hd] = st.m * SM_C + __builtin_amdgcn_logf(lt);
}
constexpr int N_IDX_UNITS = 2 * 544, N_DIL_WU = 2 * 3 * 2 * 128, N_P6_UNITS = N_IDX_UNITS + N_DIL_WU / NWAVES;
__device__ __forceinline__ void p6_phase(Frame& F, const bf16* proj, bf16* ymix, float* scores, float* lse) {
    for (int u = F.bid; u < N_P6_UNITS; u += F.G) {
        if (u < N_IDX_UNITS) { const int b = u / 544; int r = u % 544; int q = 0; while (r >= 4 * (q + 1)) { r -= 4 * (q + 1); ++q; }
            const int tt = 4 * q + r / (q + 1), kc = r % (q + 1);
            indexer_unit(F, proj, scores, b, tt, kc); }
        else dilated_unit(F, proj, ymix, lse, (u - N_IDX_UNITS) * NWAVES + F.wave);
    }
}

constexpr float DSA_THR = 8.0f / SM_C;
constexpr int VROW2 = 288;
using pg8::swap16; using pg8::swap32; using pg8::xadd16; using pg8::xadd32;
__device__ __forceinline__ float xmax16(float v) { float a = v, b = v; swap16(a, b); return fmaxf(a, b); }
__device__ __forceinline__ float xmax32(float v) { float a = v, b = v; swap32(a, b); return fmaxf(a, b); }
__device__ __forceinline__ void dsa_attn(Frame& F, const bf16* proj, bf16* ymix, int m, int b, int nsel, LAS int* list, LAS unsigned char* vl) {
    const int lane = F.lane, c16 = lane & 15, g = lane >> 4, r32 = lane & 31, hi = lane >> 5;
    bf16x8 qf[4];
    { const bf16* qp = proj + (size_t)m * LDPP + P_QB + (c16 < 6 ? c16 : 0) * 128 + 8 * g;
#pragma unroll
      for (int ks = 0; ks < 4; ++ks) { qf[ks] = *(const bf16x8*)(qp + 32 * ks); if (c16 >= 6) qf[ks] = (bf16x8){0, 0, 0, 0, 0, 0, 0, 0}; } }
    f32x4 o[8];
#pragma unroll
    for (int d = 0; d < 8; ++d) o[d] = (f32x4){0.f, 0.f, 0.f, 0.f};
    float mrun = -1e30f, lrun = 0.f;
    const int ntile = (nsel + 31) >> 5;
    const bf16* kvb = (const bf16*)(F.ws + WS_KV) + (size_t)(b * SEQ) * 256;
    bf16x8 ka[8], kb8[8], vv[8];
    const LAS unsigned char* vb = vl + (4 * g + (c16 >> 2)) * VROW2 + (4 * (c16 & 3)) * 2;
#define DSA_LOADK(KDST, KT) do { const int s0_ = (KT) * 32 + c16, s1_ = s0_ + 16; k0_ = s0_ < nsel ? list[s0_] : 0; k1_ = s1_ < nsel ? list[s1_] : 0; \
        const bf16* p0_ = kvb + (size_t)k0_ * 256 + 8 * g; const bf16* p1_ = kvb + (size_t)k1_ * 256 + 8 * g; \
        _Pragma("unroll") for (int ks = 0; ks < 4; ++ks) { KDST[ks] = *(const bf16x8*)(p0_ + 32 * ks); KDST[4 + ks] = *(const bf16x8*)(p1_ + 32 * ks); } } while (0)
#define DSA_LOADV() do {   \
        _Pragma("unroll") for (int i = 0; i < 8; ++i) { const int sl_ = vkt_ * 32 + 8 * (i >> 1) + (lane >> 3); const int kk_ = sl_ < nsel ? list[sl_] : 0; \
            vv[i] = *(const bf16x8*)(kvb + (size_t)kk_ * 256 + 128 + 8 * (8 * (i & 1) + (lane & 7))); } } while (0)
#define DSA_TILE(KCUR, KNXT, KT) do { \
        const int ktn_ = (KT) + 1 < ntile ? (KT) + 1 : (KT); \
        DSA_LOADK(KNXT, ktn_); \
        __builtin_amdgcn_sched_barrier(0); \
        f32x4 sa = (f32x4){0.f, 0.f, 0.f, 0.f}, sb = (f32x4){0.f, 0.f, 0.f, 0.f}; \
        _Pragma("unroll") for (int ks = 0; ks < 4; ++ks) { sa = __builtin_amdgcn_mfma_f32_16x16x32_bf16(KCUR[ks], qf[ks], sa, 0, 0, 0); sb = __builtin_amdgcn_mfma_f32_16x16x32_bf16(KCUR[4 + ks], qf[ks], sb, 0, 0, 0); } \
        _Pragma("unroll") for (int i = 0; i < 8; ++i) *(LAS bf16x8*)(vl + (8 * (i >> 1) + (lane >> 3)) * VROW2 + (8 * (i & 1) + (lane & 7)) * 16) = vv[i]; \
        vkt_ = ktn_; DSA_LOADV(); \
        __builtin_amdgcn_sched_barrier(0); \
        const int kb_ = (KT) * 32 + 4 * g; float mx = -INFINITY; \
        _Pragma("unroll") for (int j = 0; j < 4; ++j) { sa[j] = (kb_ + j < nsel) ? sa[j] : -INFINITY; sb[j] = (kb_ + 16 + j < nsel) ? sb[j] : -INFINITY; mx = fmaxf(mx, fmaxf(sa[j], sb[j])); } \
        if (__builtin_amdgcn_ballot_w64(mx > mrun + DSA_THR) != 0ull) {     \
            mx = xmax16(mx); mx = xmax32(mx); \
            const float mn = fmaxf(mrun, mx), alpha = __builtin_amdgcn_exp2f((mrun - mn) * SM_C); mrun = mn; lrun *= alpha; \
            _Pragma("unroll") for (int d = 0; d < 8; ++d) o[d] = o[d] * alpha; } \
        const float mc = -mrun * SM_C; float ps = 0.f; \
        _Pragma("unroll") for (int j = 0; j < 4; ++j) { sa[j] = __builtin_amdgcn_exp2f(fmaf(sa[j], SM_C, mc)); sb[j] = __builtin_amdgcn_exp2f(fmaf(sb[j], SM_C, mc)); ps += sa[j] + sb[j]; } \
        lrun += ps; \
        v4u pw; pw.x = pg8::cvt_pk_bf16(sa[0], sa[1]); pw.y = pg8::cvt_pk_bf16(sa[2], sa[3]); pw.z = pg8::cvt_pk_bf16(sb[0], sb[1]); pw.w = pg8::cvt_pk_bf16(sb[2], sb[3]); \
        const bf16x8 pf = __builtin_bit_cast(bf16x8, pw); \
        _Pragma("unroll") for (int d = 0; d < 8; ++d) { const s16x4 lo = vtr(vb + 32 * d), h8 = vtr(vb + 16 * VROW2 + 32 * d); \
            const bf16x8 a = __builtin_shufflevector(lo, h8, 0, 1, 2, 3, 4, 5, 6, 7); \
            o[d] = __builtin_amdgcn_mfma_f32_16x16x32_bf16(a, pf, o[d], 0, 0, 0); } \
        __builtin_amdgcn_sched_barrier(0); } while (0)
    int k0_, k1_, vkt_ = 0;
    DSA_LOADK(ka, 0); DSA_LOADV();
    for (int kt = 0; kt < ntile; kt += 2) {
        DSA_TILE(ka, kb8, kt);
        if (kt + 1 < ntile) DSA_TILE(kb8, ka, kt + 1);
    }
#undef DSA_TILE
#undef DSA_LOADV
#undef DSA_LOADK
    const float lt = xadd32(xadd16(lrun)), inv = 1.0f / lt;
    if (c16 < 6) { bf16* op = ymix + (size_t)m * D + Y_B + c16 * 128 + 4 * g;
#pragma unroll
        for (int d = 0; d < 8; ++d) { v2u w; w.x = pk2(o[d][0] * inv, o[d][1] * inv); w.y = pk2(o[d][2] * inv, o[d][3] * inv); *(v2u*)(op + 16 * d) = w; } }
}

__device__ __forceinline__ unsigned f2ord(float f) { const unsigned b = __builtin_bit_cast(unsigned, f); return b ^ ((unsigned)((int)b >> 31) | 0x80000000u); }
typedef unsigned short u16x2 __attribute__((ext_vector_type(2)));
__device__ __forceinline__ int wave_sum_i(int v) {
    v += __builtin_amdgcn_update_dpp(0, v, 0xB1, 0xF, 0xF, false);
    v += __builtin_amdgcn_update_dpp(0, v, 0x4E, 0xF, 0xF, false);
    v += __builtin_amdgcn_update_dpp(0, v, 0x141, 0xF, 0xF, false);
    v += __builtin_amdgcn_update_dpp(0, v, 0x140, 0xF, 0xF, false);
    return __builtin_amdgcn_readlane(v, 0) + __builtin_amdgcn_readlane(v, 16) + __builtin_amdgcn_readlane(v, 32) + __builtin_amdgcn_readlane(v, 48);
}
__device__ __forceinline__ unsigned pk_count_gt(unsigned acc, unsigned h, unsigned C, unsigned one2) {
    unsigned d; asm("v_pk_sub_u16 %0, %1, %2 clamp\n\tv_pk_min_u16 %0, %0, %3\n\tv_pk_add_u16 %0, %0, %4" : "=&v"(d) : "v"(h), "v"(C), "v"(one2), "v"(acc)); return d; }
__device__ __forceinline__ int lane_prefix(unsigned long long mask) { return __builtin_amdgcn_mbcnt_hi((unsigned)(mask >> 32), __builtin_amdgcn_mbcnt_lo((unsigned)mask, 0u)); }
__device__ __forceinline__ void p7_phase(Frame& F, const bf16* proj, bf16* ymix, const float* scores, const float* lse, const int pmode  ) {
    const int lane = F.lane;
    LAS unsigned char* vl = F.lds + F.wave * VTILE;
    LAS int* list = (LAS int*)(F.lds + NWAVES * VTILE + F.wave * 2048);
    LAS unsigned* cand = (LAS unsigned*)(F.lds + NWAVES * VTILE + F.wave * 2048 + 1024);
    const int per_b = F.NGW >> 1;
    for (int it = (F.bid >> 1) * NWAVES + F.wave; it < SEQ; it += per_b) {
        const int b = F.bid & 1, t = it, m = b * SEQ + t;
        int ln = lane; asm volatile("" : "+v"(ln));
        { float ls[6];
#pragma unroll
          for (int i = 0; i < 6; ++i) ls[i] = lse[(size_t)m * 6 + i];
          unsigned* yc = (unsigned*)(ymix + (size_t)m * D + Y_C);
#pragma unroll
          for (int hh = 0; hh < 2; ++hh) { const float mx = fmaxf(ls[hh], fmaxf(ls[2 + hh], ls[4 + hh]));
              const float e0 = __builtin_amdgcn_exp2f(ls[hh] - mx), e1 = __builtin_amdgcn_exp2f(ls[2 + hh] - mx), e2 = __builtin_amdgcn_exp2f(ls[4 + hh] - mx), rs = 1.0f / (e0 + e1 + e2);
              const float al[3] = {e0 * rs, e1 * rs, e2 * rs};
#pragma unroll
              for (int g = 0; g < 3; ++g) { const int idx = (g * 2 + hh) * 64 + lane; const unsigned w = yc[idx]; yc[idx] = pk2(bf_lo(w) * al[g], bf_hi(w) * al[g]); } } }
        unsigned u[64];
        { const float* sp = scores + (size_t)m * SEQ + ln; float f[64];
#pragma unroll
          for (int j = 0; j < 32; ++j) f[j] = __builtin_nontemporal_load(sp + j * 64);
          if (t >= 2048) {
#pragma unroll
              for (int j = 32; j < 64; ++j) f[j] = __builtin_nontemporal_load(sp + j * 64);
          } else {
#pragma unroll
              for (int j = 32; j < 64; ++j) f[j] = 0.f;
          }
#pragma unroll
          for (int j = 0; j < 64; ++j) u[j] = (ln <= t - j * 64) ? f2ord(f[j]) : 0u; }
        unsigned B = 0u; int need = 0, nb = 0;
        if (t + 1 > 256 && !(pmode & 2)) {
            unsigned h[32];
#pragma unroll
            for (int jj = 0; jj < 32; ++jj) h[jj] = (u[2 * jj] >> 16) | (u[2 * jj + 1] & 0xffff0000u);
            int cge = t + 1, cgt = 0;
            for (int bit = 15; bit >= 0; --bit) {
                const unsigned cnd = B | (1u << bit), cm1 = cnd - 1u;
                const unsigned C = cm1 | (cm1 << 16), one2 = 0x00010001u;
                unsigned acc = 0u;
#pragma unroll
                for (int jj = 0; jj < 32; ++jj) acc = pk_count_gt(acc, h[jj], C, one2);
                const unsigned a = acc;
                const int cnt = wave_sum_i((int)((a & 0xffffu) + (a >> 16)));
                if (cnt >= 256) { B = cnd; cge = cnt; } else cgt = cgt;
            }
            { const unsigned C = B | (B << 16), one2 = 0x00010001u; unsigned acc = 0u;
#pragma unroll
              for (int jj = 0; jj < 32; ++jj) acc = pk_count_gt(acc, h[jj], C, one2);
              const unsigned a = acc; cgt = wave_sum_i((int)((a & 0xffffu) + (a >> 16))); }
            need = 256 - cgt; nb = cge - cgt;
        }
        int nsel = 0, ncand = 0;
#pragma unroll
        for (int j = 0; j < 64; ++j) {
            const unsigned hv = u[j] >> 16;
            const bool gt = hv > B;
            const unsigned long long mg = __ballot(gt);
            if (gt) list[nsel + lane_prefix(mg)] = j * 64 + ln;
            nsel += __popcll(mg);
            if (B != 0u) { const bool eq = hv == B; const unsigned long long me = __ballot(eq);
                if (me != 0ull) { const int p = ncand + lane_prefix(me); if (eq && p < 64) { cand[2 * p] = u[j]; cand[2 * p + 1] = (unsigned)(j * 64 + ln); } ncand += __popcll(me); } }
            if ((j & 3) == 3) __builtin_amdgcn_sched_barrier(0);
        }
        if (need > 0) {
            const int nc = ncand < 64 ? ncand : 64;
            const unsigned cv = lane < nc ? cand[2 * lane] : 0u, ck = lane < nc ? cand[2 * lane + 1] : 0xffffffffu;
            int rank = 0;
            for (int j = 0; j < nc; ++j) { const unsigned sv = __builtin_amdgcn_readlane(cv, j), sk = __builtin_amdgcn_readlane(ck, j); rank += (sv > cv || (sv == cv && sk < ck)) ? 1 : 0; }
            const bool take = lane < nc && rank < need;
            const unsigned long long mt = __ballot(take);
            if (take) list[nsel + lane_prefix(mt)] = (int)ck;
            nsel += __popcll(mt);
        }
        if (pmode & 2) nsel = nsel > 256 ? 256 : nsel;
        (void)nb;
        if (!(pmode & 1)) dsa_attn(F, proj, ymix, m, b, nsel, list, vl);
    }
}

constexpr int PH_PRO = 0, PH_PER_LAYER = 9, PH_FINAL = 1 + DEPTH * PH_PER_LAYER, N_PHASES = PH_FINAL + 1;
__global__ void __launch_bounds__(NWAVES * 64, 2) fwd_kernel(Args args) {
    extern __shared__ __attribute__((aligned(16))) unsigned char lds[];
    Frame F;
    F.lds = (LAS unsigned char*)lds; F.tid = threadIdx.x; F.lane = F.tid & 63; F.wave = __builtin_amdgcn_readfirstlane(F.tid >> 6); F.bid = blockIdx.x;
    const int wave0 = F.wave;
    F.G = gridDim.x; F.gw = blockIdx.x * NWAVES + F.wave; F.NGW = F.G * NWAVES; F.ws = args.ws;
    volatile LAS unsigned* MISC = (volatile LAS unsigned*)(F.lds + MISC_OFF);
    for (int i = F.tid; i < (LDS_BYTES - RING_BYTES) / 4; i += NWAVES * 64) ((LAS unsigned*)(F.lds + RING_BYTES))[i] = 0u;
    __syncthreads();
    const int lo = args.ph_lo, hi = args.ph_hi;
    XcdBarrier bar; bar.bar = (unsigned*)(args.ws + WS_CTL) + CW_BAR; bar.x = 0; bar.st = nullptr;
    if (hi - lo > 1) bar = xcd_barrier_post((unsigned*)(args.ws + WS_CTL) + CW_BAR, MISC + 8);
#define IN(k) (lo <= (k) && (k) < hi)
#ifndef PHMASK
#define PHMASK 0xFFFF
#endif
#define PHM(b) ((PHMASK >> (b)) & 1)
#define RELANE() do { int w_ = wave0, b_ = blockIdx.x; asm volatile("" : "+s"(w_), "+s"(b_)); int l_; asm volatile("v_mbcnt_lo_u32_b32 %0, -1, 0\n\tv_mbcnt_hi_u32_b32 %0, -1, %0" : "=v"(l_)); F.wave = w_; F.bid = b_; F.lane = l_; F.tid = w_ * 64 + l_; F.gw = b_ * NWAVES + w_; } while (0)
#define SEAM(k) do { if (IN(k) && IN((k) + 1)) xcd_barrier(bar); } while (0)
    float* X = args.out;
    bf16* XB = (bf16*)(args.ws + WS_XN); float* RSS = (float*)(args.ws + WS_RSS); bf16* YMIX = (bf16*)(args.ws + WS_YMIX); bf16* HB = (bf16*)(args.ws + WS_H); bf16* PROJ = (bf16*)(args.ws + WS_PROJ);
    float* SCORES = (float*)(args.ws + WS_SCORES); float* LSE = (float*)(args.ws + WS_LSE);

#ifndef PROBEMASK
#define PROBEMASK 0
#endif
#ifndef PROBE_NX
#define PROBE_NX 4
#endif
#define XPM(b) ((PROBEMASK >> (b)) & 1)
#ifndef PROBE_P7MODE
#define PROBE_P7MODE 0
#endif
#define PHASE(k, b, ...) do { if (PHM(b) && (extra ? XPM(b) : IN(k))) { RELANE(); __VA_ARGS__ } if (extra ? XPM(b) : (IN(k) && IN((k) + 1))) xcd_barrier(bar); } while (0)
    { for (int r_ = 0; r_ < 1 + XPM(0) * PROBE_NX; ++r_) { if (r_) xcd_barrier(bar); if (PHM(0) && IN(PH_PRO)) { RELANE(); prologue(F, args); } } SEAM(PH_PRO); }

    for (int Lx = 0; Lx < DEPTH + (PROBEMASK ? PROBE_NX : 0); ++Lx) {
        const bool extra = Lx >= DEPTH; const int L = extra ? DEPTH - 1 : Lx;
        const int pb = 1 + L * PH_PER_LAYER;
        if (!extra && (hi <= pb || lo >= pb + PH_PER_LAYER)) continue;
        if (extra && !IN(PH_FINAL)) continue;
        const float rs = extra ? 0.f : 1.f;
        unsigned char* wl = args.ws + WS_W + (size_t)L * WL_STRIDE;
        PHASE(pb + 0, 2, pg8::Gemm g{XB, (const bf16*)(wl + WL_GU1), M, 2 * FF, D}; pg8::StaticOrder S; S.init(M, 2 * FF, F.G, F.bid); pg8::EpiSwiglu E{HB, FF, RSS, D};
            pg8::gemm_phase<pg8::EpiSwiglu, pg8::StaticOrder, true, true>(F.lds, g, S, E, F.tid););
        PHASE(pb + 1, 3, pg8::Gemm g{HB, (const bf16*)(wl + WL_D1), M, D, FF}; pg8::StaticOrder S; S.init(M, D, F.G, F.bid); pg8::EpiResid E{L == 0 ? IN_X : X, X, XB, RSS, D, 0.5f * rs};
            pg8::gemm_phase<pg8::EpiResid, pg8::StaticOrder, true, true>(F.lds, g, S, E, F.tid););
        PHASE(pb + 2, 4, pg8::Gemm g{XB, (const bf16*)(wl + WL_IN), M, LDP, D}; pg8::StaticOrder S; S.init(M, LDP, F.G, F.bid); pg8::EpiStoreBf16 E{PROJ, LDPP, RSS, D};
            pg8::gemm_phase<pg8::EpiStoreBf16, pg8::StaticOrder, true, true>(F.lds, g, S, E, F.tid););
        PHASE(pb + 3, 5, rope_conv_phase(F, PROJ, YMIX, IN_CW + L * 3 * 512););
        PHASE(pb + 4, 6, p6_phase(F, PROJ, YMIX, SCORES, LSE););
        PHASE(pb + 5, 7, p7_phase(F, PROJ, YMIX, SCORES, LSE, extra ? PROBE_P7MODE : 0););
        PHASE(pb + 6, 8, pg8::Gemm g{YMIX, (const bf16*)(wl + WL_OUT), M, D, D}; pg8::StaticOrder S; S.init(M, D, F.G, F.bid); pg8::EpiResid E{X, X, XB, RSS, D, rs};
            pg8::gemm_phase<pg8::EpiResid, pg8::StaticOrder, true, true>(F.lds, g, S, E, F.tid););
        PHASE(pb + 7, 2, pg8::Gemm g{XB, (const bf16*)(wl + WL_GU2), M, 2 * FF, D}; pg8::StaticOrder S; S.init(M, 2 * FF, F.G, F.bid); pg8::EpiSwiglu E{HB, FF, RSS, D};
            pg8::gemm_phase<pg8::EpiSwiglu, pg8::StaticOrder, true, true>(F.lds, g, S, E, F.tid););
        PHASE(pb + 8, 3, pg8::Gemm g{HB, (const bf16*)(wl + WL_D2), M, D, FF}; pg8::StaticOrder S; S.init(M, D, F.G, F.bid); pg8::EpiResid E{X, X, XB, RSS, D, 0.5f * rs};
            pg8::gemm_phase<pg8::EpiResid, pg8::StaticOrder, true, true>(F.lds, g, S, E, F.tid););
    }
    if (PHM(9) && IN(PH_FINAL)) { RELANE(); final_norm_phase(F, X, IN_NF); }
#undef IN
#undef SEAM
}

#ifndef MK_PER_PHASE
#define MK_PER_PHASE 0
#endif
extern "C" void kernel_launch(void* const* d_in, const int* in_sizes, int n_in, void* d_out, int out_size, void* d_ws, size_t ws_size, hipStream_t stream) {
    static int grid = 0;
    if (grid == 0) {
        if (n_in != 15 || out_size != M * D || ws_size < WS_END) { fprintf(stderr, "kernel_launch: unexpected shapes (n_in %d, out %d, ws %zu < %zu); nothing launched\n", n_in, out_size, ws_size, (size_t)WS_END); grid = -1; return; }
        int dev = 0, cus = 0, per_cu = 0;
        if (hipGetDevice(&dev) != hipSuccess || hipDeviceGetAttribute(&cus, hipDeviceAttributeMultiprocessorCount, dev) != hipSuccess) { grid = -1; return; }
        if (hipFuncSetAttribute((const void*)fwd_kernel, hipFuncAttributeMaxDynamicSharedMemorySize, LDS_BYTES) != hipSuccess) { fprintf(stderr, "kernel_launch: hipFuncSetAttribute failed\n"); grid = -1; return; }
        if (hipOccupancyMaxActiveBlocksPerMultiprocessor(&per_cu, (const void*)fwd_kernel, NWAVES * 64, LDS_BYTES) != hipSuccess || per_cu < 1) fprintf(stderr, "kernel_launch: occupancy query says %d\n", per_cu);
        (void)hipGetLastError();
        grid = cus;
    }
    if (grid < 0) return;
    if (hipMemsetAsync((char*)d_ws + WS_CTL, 0, CTL_ZERO_BYTES, stream) != hipSuccess) return;
    Args a{};
    for (int i = 0; i < 15; ++i) a.in[i] = d_in[i];
    a.out = (float*)d_out; a.ws = (unsigned char*)d_ws;
#if MK_PER_PHASE
    for (int p = 0; p < N_PHASES; ++p) { a.ph_lo = p; a.ph_hi = p + 1; hipLaunchKernelGGL(fwd_kernel, dim3(grid), dim3(NWAVES * 64), LDS_BYTES, stream, a); }
#else
    a.ph_lo = 0; a.ph_hi = N_PHASES;
    hipLaunchKernelGGL(fwd_kernel, dim3(grid), dim3(NWAVES * 64), LDS_BYTES, stream, a);
#endif
}
```

```cpp
#include <hip/hip_runtime.h>
#include <cstdio>
#include <cstdint>
namespace pg8 {
#define PG8_LAS __attribute__((address_space(3)))
typedef unsigned short bf16_t;
typedef short bf16x8 __attribute__((ext_vector_type(8)));
typedef float f32x4 __attribute__((ext_vector_type(4)));
typedef unsigned u32x4 __attribute__((ext_vector_type(4)));
constexpr int BM = 256, BK = 64, HALF = 128, HTB = HALF * BK * 2  , STAGE_BYTES = 8 * HTB, NXCD = 8, WGM = 8;

__host__ __device__ __forceinline__ int lds_byte(int r, int c) { const int st = (r >> 4) * 2 + (c >> 5), rr = r & 15, cc = c & 31, ob = rr * 64 + cc * 2; return st * 1024 + (ob ^ (((ob >> 9) & 1) << 5)); }
__host__ __device__ __forceinline__ void stage_rc(int b, int& R, int& C) { const int st = b / 1024, sb = b % 1024, swz = sb ^ (((sb >> 9) & 1) << 5); R = (st >> 1) * 16 + swz / 64; C = (st & 1) * 32 + (swz % 64) / 2; }
__host__ __device__ __forceinline__ int perm32(int rho) { const int n = rho >> 4, i = rho & 15; return 8 * (i >> 2) + 4 * n + (i & 3); }

struct Unit { int pm, pn; };
struct Gemm { const bf16_t* A; const bf16_t* Bt; int M, N, K; };

struct StaticOrder {
    int nM, nN, nwg, G, c;
    __host__ __device__ void init(int M, int N, int G_, int c_) { nM = M / BM; nN = N / BM; nwg = nM * nN; G = G_; c = c_; }
    __host__ __device__ bool next(int i, Unit& u) const {
        const long L = (long)i * G + c; if (L >= nwg) return false;
        int wgid = (int)L; { const int q = nwg / NXCD, r = nwg % NXCD, xcd = wgid % NXCD, off = wgid / NXCD; wgid = (xcd < r ? xcd * (q + 1) : r * (q + 1) + (xcd - r) * q) + off; }
        const int nig = WGM * nN, gid = wgid / nig, fm = gid * WGM, gsz = (nM - fm) < WGM ? (nM - fm) : WGM;
        u.pm = fm + ((wgid % nig) % gsz); u.pn = (wgid % nig) / gsz; return true;
    }
    __device__ __forceinline__ void a_ready(const Unit&) const {}
    __device__ __forceinline__ void done(const Unit&) const {}
};

__device__ __forceinline__ unsigned cvt_pk_bf16(float lo, float hi) { unsigned r; asm volatile("v_cvt_pk_bf16_f32 %0, %1, %2" : "=v"(r) : "v"(lo), "v"(hi)); return r; }
typedef float f32x2 __attribute__((ext_vector_type(2)));
__device__ __forceinline__ void swap16(float& a, float& b) { asm volatile("s_nop 1\n\tv_permlane16_swap_b32 %0, %1" : "+v"(a), "+v"(b)); }
__device__ __forceinline__ void swap32(float& a, float& b) { asm volatile("s_nop 1\n\tv_permlane32_swap_b32 %0, %1" : "+v"(a), "+v"(b)); }
__device__ __forceinline__ float xadd16(float v) { float a = v, b = v; swap16(a, b); return a + b; }
__device__ __forceinline__ float xadd32(float v) { float a = v, b = v; swap32(a, b); return a + b; }
constexpr float RMS_EPS_ = 1e-6f;
__device__ __forceinline__ void row_rsqrt(const float* rss, int row0, int fq, int ncols, float (&rr)[2][4]) {
    if (!rss) {
#pragma unroll
        for (int i = 0; i < 8; ++i) rr[i >> 2][i & 3] = 1.0f;
        return; }
    f32x4 pa[8], pb[8];
#pragma unroll
    for (int i = 0; i < 8; ++i) { const f32x4* p = (const f32x4*)(rss + (size_t)(row0 + (i >> 2) * HALF + (i & 3) * 16) * 32 + fq * 8); pa[i] = p[0]; pb[i] = p[1]; }
#pragma unroll
    for (int i = 0; i < 8; ++i) { const f32x4 a = pa[i], b = pb[i];
        float s = ((a[0] + a[1]) + (a[2] + a[3])) + ((b[0] + b[1]) + (b[2] + b[3])); s = xadd16(s); s = xadd32(s);
        rr[i >> 2][i & 3] = __builtin_amdgcn_rsqf(s * (1.0f / (float)ncols) + RMS_EPS_); }
}
struct EpiStoreBf16 {
    static constexpr bool PERM = true, AFTER_DRAIN = false;
    bf16_t* O; int ldc; const float* rss; int ncols;
    __device__ __forceinline__ void operator()(const f32x4 (&acc)[2][2][4][2], const Unit& u, int wr, int wc, int fr, int fq) const {
        const int row0 = u.pm * BM + wr * 64 + fr, col0 = u.pn * BM + wc * 32 + 8 * fq;
        float rr[2][4]; row_rsqrt(rss, row0, fq, ncols, rr);
#pragma unroll
        for (int ai = 0; ai < 2; ++ai)
#pragma unroll
            for (int m = 0; m < 4; ++m) { bf16_t* rowp = O + (size_t)(row0 + ai * HALF + m * 16) * ldc + col0; const float r = rr[ai][m];
#pragma unroll
                for (int bj = 0; bj < 2; ++bj) { const f32x4 v0 = acc[ai][bj][m][0] * r, v1 = acc[ai][bj][m][1] * r;
                    u32x4 w; w.x = cvt_pk_bf16(v0[0], v0[1]); w.y = cvt_pk_bf16(v0[2], v0[3]); w.z = cvt_pk_bf16(v1[0], v1[1]); w.w = cvt_pk_bf16(v1[2], v1[3]);
                    *(u32x4*)(rowp + bj * HALF) = w; } }
    }
};
struct EpiSwiglu {
    static constexpr bool PERM = true, AFTER_DRAIN = false;
    bf16_t* H; int ldh; const float* rss; int ncols;
    __device__ __forceinline__ static float silu_mul(float g, float u) { return g * u * __builtin_amdgcn_rcpf(1.0f + __builtin_amdgcn_exp2f(-1.4426950408889634f * g)); }
    __device__ __forceinline__ void operator()(const f32x4 (&acc)[2][2][4][2], const Unit& u, int wr, int wc, int fr, int fq) const {
        const int row0 = u.pm * BM + wr * 64 + fr, col0 = u.pn * HALF + wc * 32 + 8 * fq;
        float rr[2][4]; row_rsqrt(rss, row0, fq, ncols, rr);
#pragma unroll
        for (int ai = 0; ai < 2; ++ai)
#pragma unroll
            for (int m = 0; m < 4; ++m) { bf16_t* rowp = H + (size_t)(row0 + ai * HALF + m * 16) * ldh + col0; const float r = rr[ai][m];
                const f32x4 g0 = acc[ai][0][m][0] * r, g1 = acc[ai][0][m][1] * r, u0 = acc[ai][1][m][0] * r, u1 = acc[ai][1][m][1] * r;
                u32x4 w;
                w.x = cvt_pk_bf16(silu_mul(g0[0], u0[0]), silu_mul(g0[1], u0[1])); w.y = cvt_pk_bf16(silu_mul(g0[2], u0[2]), silu_mul(g0[3], u0[3]));
                w.z = cvt_pk_bf16(silu_mul(g1[0], u1[0]), silu_mul(g1[1], u1[1])); w.w = cvt_pk_bf16(silu_mul(g1[2], u1[2]), silu_mul(g1[3], u1[3]));
                *(u32x4*)rowp = w; }
    }
};
struct EpiResid {
    static constexpr bool PERM = true, AFTER_DRAIN = false;
    const float* src; float* dst; bf16_t* xb; float* rss; int ldc; float scale;
    __device__ __forceinline__ void operator()(const f32x4 (&acc)[2][2][4][2], const Unit& u, int wr, int wc, int fr, int fq) const {
        const int row0 = u.pm * BM + wr * 64 + fr, col0 = u.pn * BM + wc * 32 + 8 * fq;
#pragma unroll
        for (int ai = 0; ai < 2; ++ai)
#pragma unroll
            for (int mp = 0; mp < 2; ++mp) {
                f32x4 b[2][2][2]; float ss[2];
#pragma unroll
                for (int q = 0; q < 2; ++q) { const size_t off = (size_t)(row0 + ai * HALF + (2 * mp + q) * 16) * ldc + col0;
#pragma unroll
                    for (int bj = 0; bj < 2; ++bj) { b[q][bj][0] = *(const f32x4*)(src + off + bj * HALF); b[q][bj][1] = *(const f32x4*)(src + off + bj * HALF + 4); } }
#pragma unroll
                for (int q = 0; q < 2; ++q) { const int m = 2 * mp + q; const size_t off = (size_t)(row0 + ai * HALF + m * 16) * ldc + col0; float s = 0.f;
#pragma unroll
                    for (int bj = 0; bj < 2; ++bj) { const f32x4 v0 = b[q][bj][0] + acc[ai][bj][m][0] * scale, v1 = b[q][bj][1] + acc[ai][bj][m][1] * scale;
                        *(f32x4*)(dst + off + bj * HALF) = v0; *(f32x4*)(dst + off + bj * HALF + 4) = v1;
                        s += ((v0[0] * v0[0] + v0[1] * v0[1]) + (v0[2] * v0[2] + v0[3] * v0[3])) + ((v1[0] * v1[0] + v1[1] * v1[1]) + (v1[2] * v1[2] + v1[3] * v1[3]));
                        u32x4 w; w.x = cvt_pk_bf16(v0[0], v0[1]); w.y = cvt_pk_bf16(v0[2], v0[3]); w.z = cvt_pk_bf16(v1[0], v1[1]); w.w = cvt_pk_bf16(v1[2], v1[3]);
                        *(u32x4*)(xb + off + bj * HALF) = w; }
                    ss[q] = s; }
#pragma unroll
                for (int q = 0; q < 2; ++q) { float s = xadd16(ss[q]); s = xadd32(s);
                    if (fq == 0) rss[(size_t)(row0 + ai * HALF + (2 * mp + q) * 16) * 32 + u.pn * 4 + wc] = s; }
                asm volatile("" ::: "memory"); }
    }
};
template <class Epi, class Sched, bool ALIGN_EPI = false, bool SP2 = false>
__device__ __forceinline__ void gemm_phase(PG8_LAS unsigned char* lds, const Gemm g, const Sched& S, const Epi& E, const int tid_in  ) {
    const int tid = tid_in, wid = __builtin_amdgcn_readfirstlane(tid >> 6), lane = tid & 63, wr = wid >> 2, wc = wid & 3, fr = lane & 15, fq = lane >> 4;
    const int K = g.K, nt = K / BK;
    unsigned voffA[2], voffB[2];
#pragma unroll
    for (int i = 0; i < 2; ++i) { int R, C; stage_rc(tid * 16 + i * 8192, R, C); const int Rb = Epi::PERM ? ((R & ~31) + perm32(R & 31)) : R;
        voffA[i] = (unsigned)(R * K + C) * 2u; voffB[i] = (unsigned)(Rb * K + C) * 2u; }
    const size_t kstep = (size_t)(BK * 2);
    const size_t hstep = (size_t)HALF * K * 2;
    const size_t tstep = 2 * hstep;
    const unsigned ldsw = (unsigned)wid * 1024u;
    const int aoff = lds_byte(wr * 64 + fr, fq * 8), boff = lds_byte(wc * 32 + fr, fq * 8);
#define PG8_SA(b, h) (((b) * 2 + (h)) * HTB)
#define PG8_SB(b, h) ((4 + (b) * 2 + (h)) * HTB)
#define PG8_STAGE(bufoff, gbase, voff) do { _Pragma("unroll") for (int _i = 0; _i < 2; ++_i) \
        __builtin_amdgcn_global_load_lds((const unsigned*)((const char*)(gbase) + (voff)[_i]), (PG8_LAS unsigned*)(lds + (bufoff) + ldsw + _i * 8192), 16, 0, 0); } while (0)
#define PG8_LDA(dst, b, h) do { _Pragma("unroll") for (int m = 0; m < 4; ++m) _Pragma("unroll") for (int k = 0; k < 2; ++k) dst[m][k] = *(const PG8_LAS bf16x8*)(lds + PG8_SA(b, h) + aoff + m * 2048 + k * 1024); } while (0)
#define PG8_LDB(dst, b, h) do { _Pragma("unroll") for (int n = 0; n < 2; ++n) _Pragma("unroll") for (int k = 0; k < 2; ++k) dst[n][k] = *(const PG8_LAS bf16x8*)(lds + PG8_SB(b, h) + boff + n * 2048 + k * 1024); } while (0)
#define PG8_MMA(ai, bj, At, Bt) do { __builtin_amdgcn_s_setprio(1); _Pragma("unroll") for (int m = 0; m < 4; ++m) _Pragma("unroll") for (int n = 0; n < 2; ++n) _Pragma("unroll") for (int k = 0; k < 2; ++k) \
        acc[ai][bj][m][n] = __builtin_amdgcn_mfma_f32_16x16x32_bf16(Bt[n][k], At[m][k], acc[ai][bj][m][n], 0, 0, 0); __builtin_amdgcn_s_setprio(0); } while (0)
#define PG8_WAIT_V(n) asm volatile("s_waitcnt vmcnt(" #n ")" ::: "memory")
#define PG8_WAIT_L(n) asm volatile("s_waitcnt lgkmcnt(" #n ")" ::: "memory")
#define PG8_BAR __builtin_amdgcn_s_barrier()
#define PG8_SCHED __builtin_amdgcn_sched_barrier(0)
    Unit cur, nxt; int ui = 0;
    if (!S.next(0, cur)) return;
    f32x4 acc[2][2][4][2];
#pragma unroll
    for (int a = 0; a < 2; ++a)
#pragma unroll
        for (int b = 0; b < 2; ++b)
#pragma unroll
            for (int m = 0; m < 4; ++m)
#pragma unroll
                for (int n = 0; n < 2; ++n) acc[a][b][m][n] = (f32x4){0.f, 0.f, 0.f, 0.f};
    bf16x8 At[4][2], B0[2][2], B1[2][2];
    const char* cA = (const char*)g.A + (size_t)cur.pm * tstep; const char* cB = (const char*)g.Bt + (size_t)cur.pn * tstep;
    S.a_ready(cur);
    if constexpr (SP2) {
        PG8_STAGE(PG8_SB(0, 0), cB, voffB); PG8_STAGE(PG8_SB(0, 1), cB + hstep, voffB); PG8_STAGE(PG8_SA(0, 0), cA, voffA); PG8_STAGE(PG8_SA(0, 1), cA + hstep, voffA);
        if (wr == 1) PG8_BAR;
        PG8_WAIT_V(2); PG8_BAR;
        PG8_STAGE(PG8_SB(1, 0), cB + kstep, voffB); PG8_STAGE(PG8_SA(1, 0), cA + kstep, voffA); PG8_STAGE(PG8_SB(1, 1), cB + hstep + kstep, voffB);
        PG8_WAIT_V(6); PG8_BAR;
    } else {
        PG8_STAGE(PG8_SB(0, 0), cB, voffB); PG8_STAGE(PG8_SA(0, 0), cA, voffA); PG8_STAGE(PG8_SB(0, 1), cB + hstep, voffB); PG8_STAGE(PG8_SA(0, 1), cA + hstep, voffA);
        if (wr == 1) PG8_BAR;
        PG8_WAIT_V(4); PG8_BAR;
        PG8_STAGE(PG8_SB(1, 0), cB + kstep, voffB); PG8_STAGE(PG8_SA(1, 0), cA + kstep, voffA); PG8_STAGE(PG8_SB(1, 1), cB + hstep + kstep, voffB);
        PG8_WAIT_V(6); PG8_BAR;
    }
    for (;;) {
        const bool has_next = S.next(ui + 1, nxt);
        const char* nA = has_next ? (const char*)g.A + (size_t)nxt.pm * tstep : cA; const char* nB = has_next ? (const char*)g.Bt + (size_t)nxt.pn * tstep : cB;
        for (int t = 0; t < nt; t += 2) {
            const bool last = (t == nt - 2);
            const char* a1 = cA + (size_t)(t + 1) * kstep;
            const char* a2 = last ? nA : cA + (size_t)(t + 2) * kstep; const char* b2 = last ? nB : cB + (size_t)(t + 2) * kstep;
            const char* a3 = a2 + kstep; const char* b3 = b2 + kstep;
            if (last && has_next) S.a_ready(nxt);
            if constexpr (SP2) {
            PG8_LDB(B0, 0, 0); PG8_LDB(B1, 0, 1); PG8_SCHED; PG8_LDA(At, 0, 0); PG8_STAGE(PG8_SA(1, 1), a1 + hstep, voffA);
            PG8_WAIT_V(8); PG8_WAIT_L(0); PG8_BAR; PG8_MMA(0, 0, At, B0); PG8_MMA(0, 1, At, B1); PG8_BAR; PG8_SCHED;
            PG8_LDA(At, 0, 1); PG8_STAGE(PG8_SB(0, 0), b2, voffB); PG8_STAGE(PG8_SB(0, 1), b2 + hstep, voffB); PG8_STAGE(PG8_SA(0, 0), a2, voffA);
            PG8_WAIT_V(8); PG8_WAIT_L(0); PG8_BAR; PG8_MMA(1, 0, At, B0); PG8_MMA(1, 1, At, B1); PG8_BAR; PG8_SCHED;
            PG8_LDB(B0, 1, 0); PG8_LDB(B1, 1, 1); PG8_SCHED; PG8_LDA(At, 1, 0); PG8_STAGE(PG8_SA(0, 1), a2 + hstep, voffA);
            PG8_WAIT_V(8); PG8_WAIT_L(0); PG8_BAR; PG8_MMA(0, 0, At, B0); PG8_MMA(0, 1, At, B1); PG8_BAR; PG8_SCHED;
            PG8_LDA(At, 1, 1); PG8_STAGE(PG8_SB(1, 0), b3, voffB); PG8_STAGE(PG8_SB(1, 1), b3 + hstep, voffB); PG8_STAGE(PG8_SA(1, 0), a3, voffA);
            PG8_WAIT_V(8); PG8_WAIT_L(0); PG8_BAR; PG8_MMA(1, 0, At, B0); PG8_MMA(1, 1, At, B1); PG8_BAR; PG8_SCHED;
            } else {
            PG8_LDB(B0, 0, 0); PG8_SCHED; PG8_LDA(At, 0, 0); PG8_STAGE(PG8_SA(1, 1), a1 + hstep, voffA);
            PG8_WAIT_L(8); PG8_BAR; PG8_WAIT_L(0); PG8_MMA(0, 0, At, B0); PG8_BAR; PG8_SCHED;
            PG8_LDB(B1, 0, 1); PG8_STAGE(PG8_SB(0, 0), b2, voffB);
            PG8_BAR; PG8_WAIT_L(0); PG8_MMA(0, 1, At, B1); PG8_BAR;
            PG8_LDA(At, 0, 1); PG8_STAGE(PG8_SA(0, 0), a2, voffA);
            PG8_BAR; PG8_WAIT_L(0); PG8_MMA(1, 0, At, B0); PG8_BAR; PG8_SCHED;
            PG8_STAGE(PG8_SB(0, 1), b2 + hstep, voffB);
            PG8_WAIT_V(6); PG8_BAR; PG8_MMA(1, 1, At, B1); PG8_BAR;
            PG8_LDB(B0, 1, 0); PG8_SCHED; PG8_LDA(At, 1, 0); PG8_STAGE(PG8_SA(0, 1), a2 + hstep, voffA);
            PG8_WAIT_L(8); PG8_BAR; PG8_WAIT_L(0); PG8_MMA(0, 0, At, B0); PG8_BAR; PG8_SCHED;
            PG8_LDB(B1, 1, 1); PG8_STAGE(PG8_SB(1, 0), b3, voffB);
            PG8_BAR; PG8_WAIT_L(0); PG8_MMA(0, 1, At, B1); PG8_BAR;
            PG8_LDA(At, 1, 1); PG8_STAGE(PG8_SA(1, 0), a3, voffA);
            PG8_BAR; PG8_WAIT_L(0); PG8_MMA(1, 0, At, B0); PG8_BAR; PG8_SCHED;
            PG8_STAGE(PG8_SB(1, 1), b3 + hstep, voffB);
            PG8_WAIT_V(6); PG8_BAR; PG8_MMA(1, 1, At, B1); PG8_BAR;
            }
        }
        if constexpr (ALIGN_EPI) { if (wr == 0) PG8_BAR; }
        if constexpr (!Epi::AFTER_DRAIN) { E(acc, cur, wr, wc, fr, fq); S.done(cur); }
        if (!has_next) break;
#pragma unroll
        for (int a = 0; a < 2; ++a)
#pragma unroll
            for (int b = 0; b < 2; ++b)
#pragma unroll
                for (int m = 0; m < 4; ++m)
#pragma unroll
                    for (int n = 0; n < 2; ++n) acc[a][b][m][n] = (f32x4){0.f, 0.f, 0.f, 0.f};
        cur = nxt; cA = nA; cB = nB; ++ui;
        if constexpr (ALIGN_EPI) { if (wr == 1) PG8_BAR; }
    }
    PG8_WAIT_V(0);
    if constexpr (!ALIGN_EPI) { if (wr == 0) PG8_BAR; }
    PG8_BAR;
    if constexpr (Epi::AFTER_DRAIN) { E.fused(acc, cur, wr, wc, fr, fq, lds, wid, lane); S.done(cur); }
#undef PG8_SA
#undef PG8_SB
#undef PG8_STAGE
#undef PG8_LDA
#undef PG8_LDB
#undef PG8_MMA
#undef PG8_WAIT_V
#undef PG8_WAIT_L
#undef PG8_BAR
#undef PG8_SCHED
}
}
#define LAS __attribute__((address_space(3)))
#define XB_TMO      128
#define XB_XCNT(j)  (256  + 64 * (j))
#define XB_XSUB(j)  (1280 + 64 * (j))
#define XB_XGEN(j)  (2304 + 64 * (j))
#define XB_TOP      3328
#define XB_TOPGEN   3392
#define XCD_BAR_WORDS 3456
#define XB_SPIN_CAP (1u << 18)

__device__ __forceinline__ unsigned xb_ld(unsigned* p)              { return __hip_atomic_load(p, __ATOMIC_RELAXED, __HIP_MEMORY_SCOPE_AGENT); }
__device__ __forceinline__ unsigned xb_add(unsigned* p, unsigned v) { return __hip_atomic_fetch_add(p, v, __ATOMIC_RELAXED, __HIP_MEMORY_SCOPE_AGENT); }
__device__ __forceinline__ unsigned xb_xcc_id() { return (unsigned)__builtin_amdgcn_s_getreg((3 << 11) | 20) & 0xFu; }
#define XB_SPIN(cond, bar) do { unsigned _sp = 0; while (cond) { __builtin_amdgcn_s_sleep(1); \
    if ((++_sp & 255u) == 0u) { if (xb_ld(&(bar)[XB_TMO])) break; if (_sp > XB_SPIN_CAP) { atomicAdd(&(bar)[XB_TMO], 1u); break; } } } } while (0)

struct XcdBarrier {
    unsigned* bar; unsigned x;
    volatile LAS unsigned* st;
};

__device__ __forceinline__ XcdBarrier xcd_barrier_post(unsigned* bar, volatile LAS unsigned* st) {
    XcdBarrier b; b.bar = bar; b.x = xb_xcc_id(); b.st = st;
    if (threadIdx.x == 0) (void)xb_add(&bar[XB_XCNT(b.x)], 1u);
    return b;
}
__device__ __forceinline__ void xcd_barrier_complete(unsigned* bar, unsigned x, unsigned& nloc, unsigned& nx) {
    const unsigned G = gridDim.x * gridDim.y * gridDim.z;
    unsigned sum, cnt, mine, sp = 0u;
    for (;;) {
        sum = 0u; cnt = 0u; mine = 0u;
#pragma unroll
        for (unsigned j = 0; j < 16; ++j) { const unsigned c = xb_ld(&bar[XB_XCNT(j)]); sum += c; cnt += (c > 0u) ? 1u : 0u; mine = (j == x) ? c : mine; }
        if (sum == G) break;
        __builtin_amdgcn_s_sleep(1);
        if ((++sp & 255u) == 0u) { if (xb_ld(&bar[XB_TMO])) break; if (sp > XB_SPIN_CAP) { atomicAdd(&bar[XB_TMO], 1u); break; } }
    }
    nloc = mine > 0u ? mine : 1u; nx = cnt > 0u ? cnt : 1u;
}

__device__ __forceinline__ void xcd_barrier(const XcdBarrier& b) {
    asm volatile("s_waitcnt vmcnt(0)" ::: "memory");
    __syncthreads();
    if (threadIdx.x == 0) {
        unsigned* bar = b.bar;
        __builtin_amdgcn_s_waitcnt(0);
        unsigned nloc = b.st[0], nx = b.st[1];
        if (nloc == 0u) { xcd_barrier_complete(bar, b.x, nloc, nx); b.st[0] = nloc; b.st[1] = nx; }
        const unsigned old = xb_add(&bar[XB_XSUB(b.x)], 1u);
        const unsigned gen = old / nloc;
        if (old + 1u == (gen + 1u) * nloc) {
            __builtin_amdgcn_fence(__ATOMIC_RELEASE, "agent");
            asm volatile("s_waitcnt vmcnt(0)" ::: "memory");
            const unsigned og = xb_add(&bar[XB_TOP], 1u);
            const unsigned tg = og / nx;
            if (og + 1u == (tg + 1u) * nx) xb_add(&bar[XB_TOPGEN], 1u);
            else XB_SPIN(xb_ld(&bar[XB_TOPGEN]) == tg, bar);
            __builtin_amdgcn_fence(__ATOMIC_ACQUIRE, "agent");
            xb_add(&bar[XB_XGEN(b.x)], 1u);
            asm volatile("s_waitcnt vmcnt(0)" ::: "memory");
        } else {
            XB_SPIN(xb_ld(&bar[XB_XGEN(b.x)]) == gen, bar);
            __builtin_amdgcn_fence(__ATOMIC_ACQUIRE, "agent");
            asm volatile("s_waitcnt vmcnt(0)" ::: "memory");
        }
    }
    __syncthreads();
}
constexpr int BATCH = 2, SEQ = 4096, M = BATCH * SEQ, D = 2048, FF = 5632, DEPTH = 4, DIN = 5968, LDP = 6144, LDPP = 6208;
constexpr int NWAVES = 8;
constexpr int P_H = 0, P_GB = 512, P_GC = 1024, P_QB = 1536, P_KB = 2304, P_VB = 2432, P_QI = 2560, P_KI = 3584, P_QC = 3648, P_KC = 4416, P_VC = 5184, P_WI = 5952;
constexpr int Y_A = 0, Y_B = 512, Y_C = 1280;
constexpr float RMS_EPS = 1e-6f;
constexpr float SM_C = 0.08838834764831845f * 1.4426950408889634f;

constexpr size_t MiB = 1u << 20;
constexpr size_t WS_CTL = 0, CTL_ZERO_BYTES = 1 * MiB;
constexpr size_t WS_COSH = 1 * MiB, WS_SINH = 3 * MiB, WS_COSI = 5 * MiB, WS_SINI = 6 * MiB, WS_LSE = 7 * MiB, WS_RSS = 257 * MiB;
constexpr size_t WS_XN = 8 * MiB, WS_YMIX = 40 * MiB, WS_H = 72 * MiB, WS_PROJ = 160 * MiB, WS_SCORES = 258 * MiB, WS_W = 386 * MiB;
constexpr size_t WL_GU1 = 0, WL_D1 = 44 * MiB, WL_IN = 66 * MiB, WL_OUT = 90 * MiB, WL_GU2 = 98 * MiB, WL_D2 = 142 * MiB, WL_STRIDE = 164 * MiB;
constexpr size_t WS_KV = WS_W + DEPTH * WL_STRIDE, WS_KI = WS_KV + 4 * MiB, WS_END = WS_KI + 1 * MiB;
static_assert((size_t)M * FF * 2 <= WS_PROJ - WS_H && (size_t)M * LDPP * 2 <= WS_RSS - WS_PROJ && WS_RSS + (size_t)M * 32 * 4 <= WS_SCORES && (size_t)M * SEQ * 4 <= WS_W - WS_SCORES, "ws map");
static_assert((size_t)2 * FF * D * 2 <= WL_D1 && (size_t)D * FF * 2 <= WL_IN - WL_D1 && (size_t)LDP * D * 2 <= WL_OUT - WL_IN && (size_t)D * D * 2 <= WL_GU2 - WL_OUT, "weight map");
constexpr int CW_BAR = 4096;

constexpr int RING_BYTES = 131072, MISC_OFF = RING_BYTES + 320, LDS_BYTES = 147456;

typedef unsigned short bf16;
typedef unsigned v4u __attribute__((ext_vector_type(4)));
typedef unsigned v2u __attribute__((ext_vector_type(2)));
typedef float f32x4 __attribute__((ext_vector_type(4)));
typedef float f32x16 __attribute__((ext_vector_type(16)));
typedef short bf16x8 __attribute__((ext_vector_type(8)));
typedef short s16x4 __attribute__((ext_vector_type(4)));

__device__ __forceinline__ unsigned f2bf(float f) { unsigned u = __builtin_bit_cast(unsigned, f); return (u + 0x7fffu + ((u >> 16) & 1u)) >> 16; }
__device__ __forceinline__ unsigned pk2(float lo, float hi) { return f2bf(lo) | (f2bf(hi) << 16); }
__device__ __forceinline__ float bf_lo(unsigned w) { return __builtin_bit_cast(float, w << 16); }
__device__ __forceinline__ float bf_hi(unsigned w) { return __builtin_bit_cast(float, w & 0xffff0000u); }
__device__ __forceinline__ float bf2f(bf16 b) { return __builtin_bit_cast(float, (unsigned)b << 16); }
__device__ __forceinline__ float wave_sum(float v) {
#pragma unroll
    for (int o = 1; o < 64; o <<= 1) v += __shfl_xor(v, o);
    return v;
}

__device__ const float INV_H[64] = {
1.000000000e+00f, 8.659643531e-01f, 7.498942018e-01f, 6.493816376e-01f, 5.623413324e-01f, 4.869675338e-01f, 4.216965139e-01f, 3.651741147e-01f, 3.162277639e-01f, 2.738419771e-01f, 2.371373922e-01f, 2.053525001e-01f, 1.778279394e-01f, 1.539926529e-01f, 1.333521456e-01f, 1.154782027e-01f, 1.000000015e-01f, 8.659642935e-02f, 7.498941571e-02f, 6.493816525e-02f, 5.623412877e-02f, 4.869675264e-02f, 4.216964915e-02f, 3.651741147e-02f, 3.162277862e-02f, 2.738419734e-02f, 2.371373586e-02f, 2.053524926e-02f, 1.778279431e-02f, 1.539926510e-02f, 1.333521493e-02f, 1.154781971e-02f, 9.999999776e-03f, 8.659643121e-03f, 7.498942316e-03f, 6.493816618e-03f, 5.623413250e-03f, 4.869675264e-03f, 4.216964822e-03f, 3.651741426e-03f, 3.162277862e-03f, 2.738419687e-03f, 2.371373819e-03f, 2.053525066e-03f, 1.778279431e-03f, 1.539926627e-03f, 1.333521446e-03f, 1.154781901e-03f, 1.000000047e-03f, 8.659643354e-04f, 7.498941850e-04f, 6.493816618e-04f, 5.623413017e-04f, 4.869675031e-04f, 4.216965463e-04f, 3.651741135e-04f, 3.162277862e-04f, 2.738419571e-04f, 2.371373848e-04f, 2.053525241e-04f, 1.778279402e-04f, 1.539926452e-04f, 1.333521504e-04f, 1.154782076e-04f };

struct Frame {
    LAS unsigned char* lds;
    int tid, lane, wave, bid, G, gw, NGW;
    unsigned char* ws;
};

template <int MODE> __device__ __forceinline__ int rowmap(int n) {
    if (MODE == 1) return 256 * (n >> 7) + (n & 127);
    if (MODE == 2) return 256 * (n >> 7) + 128 + (n & 127);
    if (MODE == 3) return n < 3648 ? n : (n < 3664 ? P_WI + (n - 3648) : n - 16);
    return n;
}
struct PItem { const float* W; bf16* WT; const float* gain; int K, N, mode, k0, n0; };
__device__ __forceinline__ int rowmap_rt(int mode, int n) { return mode == 1 ? rowmap<1>(n) : (mode == 2 ? rowmap<2>(n) : (mode == 3 ? rowmap<3>(n) : n)); }
__device__ __forceinline__ void pitem_load(const PItem& p, int lane, float (&w)[32]) {
    const int nn = p.n0 + (lane & 31); const int nc = nn < p.N ? nn : p.n0;
#pragma unroll
    for (int i = 0; i < 32; ++i) w[i] = p.W[(size_t)(p.k0 + 2 * i + (lane >> 5)) * p.N + nc];
}
__device__ __forceinline__ void pitem_store(const PItem& p, int lane, LAS float* scr, const float (&w)[32]) {
    const int c = lane & 7; const bool nok = p.n0 + (lane & 31) < p.N;
    float gv[8];
    if (p.gain) { const f32x4 g0 = *(const f32x4*)(p.gain + p.k0 + 8 * c), g1 = *(const f32x4*)(p.gain + p.k0 + 8 * c + 4); gv[0] = g0[0]; gv[1] = g0[1]; gv[2] = g0[2]; gv[3] = g0[3]; gv[4] = g1[0]; gv[5] = g1[1]; gv[6] = g1[2]; gv[7] = g1[3]; }
    else {
#pragma unroll
        for (int e = 0; e < 8; ++e) gv[e] = 1.0f; }
#pragma unroll
    for (int i = 0; i < 32; ++i) scr[(2 * i + (lane >> 5)) * 33 + (lane & 31)] = nok ? w[i] : 0.f;
    asm volatile("s_waitcnt lgkmcnt(0)" ::: "memory");
#pragma unroll
    for (int j = 0; j < 4; ++j) { const int n = (lane >> 3) + 8 * j; const LAS float* s = scr + (8 * c) * 33 + n;
        v4u o; o.x = pk2(s[0 * 33] * gv[0], s[1 * 33] * gv[1]); o.y = pk2(s[2 * 33] * gv[2], s[3 * 33] * gv[3]); o.z = pk2(s[4 * 33] * gv[4], s[5 * 33] * gv[5]); o.w = pk2(s[6 * 33] * gv[6], s[7 * 33] * gv[7]);
        if (p.n0 + n < p.N) *(v4u*)(p.WT + (size_t)rowmap_rt(p.mode, p.n0 + n) * p.K + p.k0 + 8 * c) = o; }
    asm volatile("s_waitcnt lgkmcnt(0)" ::: "memory");
}
__device__ __forceinline__ void sincos_d(double a, float& sn, float& cs) {
    const double k = __builtin_rint(a * 0.63661977236758134308);
    double r = __builtin_fma(-k, 1.57079632679489655800e+00, a); r = __builtin_fma(-k, 6.12323399573676603587e-17, r);
    const int q = (int)((long long)k & 3);
    const double r2 = r * r;
    double s = -1.0 / 39916800.0; s = s * r2 + 1.0 / 362880.0; s = s * r2 - 1.0 / 5040.0; s = s * r2 + 1.0 / 120.0; s = s * r2 - 1.0 / 6.0; s = s * r2 * r + r;
    double c = 1.0 / 479001600.0; c = c * r2 - 1.0 / 3628800.0; c = c * r2 + 1.0 / 40320.0; c = c * r2 - 1.0 / 720.0; c = c * r2 + 1.0 / 24.0; c = c * r2 - 0.5; c = c * r2 + 1.0;
    const double ss = (q & 1) ? c : s, cc = (q & 1) ? s : c;
    sn = (float)((q & 2) ? -ss : ss); cs = (float)(((q + 1) & 2) ? -cc : cc);
}
struct Args { const void* in[15]; float* out; unsigned char* ws; int ph_lo, ph_hi; };
#define IN_X ((const float*)args.in[0])
#define IN_POS ((const int*)args.in[1])
#define IN_N1 ((const float*)args.in[2])
#define IN_G1 ((const float*)args.in[3])
#define IN_U1 ((const float*)args.in[4])
#define IN_D1 ((const float*)args.in[5])
#define IN_NM ((const float*)args.in[6])
#define IN_WIN ((const float*)args.in[7])
#define IN_CW ((const float*)args.in[8])
#define IN_WOUT ((const float*)args.in[9])
#define IN_N2 ((const float*)args.in[10])
#define IN_G2 ((const float*)args.in[11])
#define IN_U2 ((const float*)args.in[12])
#define IN_D2 ((const float*)args.in[13])
#define IN_NF ((const float*)args.in[14])
__device__ __forceinline__ void prologue(Frame& F, const Args& args) {
    LAS float* scr = (LAS float*)(F.lds + F.wave * 16384);
    constexpr int I_G = (D / 64) * (FF / 32), I_D = (FF / 64) * (D / 32), I_IN = (D / 64) * ((DIN + 31) / 32), I_OUT = (D / 64) * (D / 32);
    constexpr int PER_LAYER = 4 * I_G + 2 * I_D + I_IN + I_OUT;
    constexpr int TOTAL = DEPTH * PER_LAYER;
#define PRO_DECODE(IT, P) do { const int L_ = (IT) / PER_LAYER; int r_ = (IT) % PER_LAYER; unsigned char* wl_ = F.ws + WS_W + (size_t)L_ * WL_STRIDE; \
        const size_t og_ = (size_t)L_ * D * FF, oin_ = (size_t)L_ * D * DIN, oout_ = (size_t)L_ * D * D; \
        if (r_ < I_G) { P.W = IN_G1 + og_; P.WT = (bf16*)(wl_ + WL_GU1); P.gain = IN_N1 + L_ * D; P.K = D; P.N = FF; P.mode = 1; } \
        else if ((r_ -= I_G) < I_G) { P.W = IN_U1 + og_; P.WT = (bf16*)(wl_ + WL_GU1); P.gain = IN_N1 + L_ * D; P.K = D; P.N = FF; P.mode = 2; } \
        else if ((r_ -= I_G) < I_D) { P.W = IN_D1 + og_; P.WT = (bf16*)(wl_ + WL_D1); P.gain = nullptr; P.K = FF; P.N = D; P.mode = 0; } \
        else if ((r_ -= I_D) < I_G) { P.W = IN_G2 + og_; P.WT = (bf16*)(wl_ + WL_GU2); P.gain = IN_N2 + L_ * D; P.K = D; P.N = FF; P.mode = 1; } \
        else if ((r_ -= I_G) < I_G) { P.W = IN_U2 + og_; P.WT = (bf16*)(wl_ + WL_GU2); P.gain = IN_N2 + L_ * D; P.K = D; P.N = FF; P.mode = 2; } \
        else if ((r_ -= I_G) < I_D) { P.W = IN_D2 + og_; P.WT = (bf16*)(wl_ + WL_D2); P.gain = nullptr; P.K = FF; P.N = D; P.mode = 0; } \
        else if ((r_ -= I_D) < I_IN) { P.W = IN_WIN + oin_; P.WT = (bf16*)(wl_ + WL_IN); P.gain = IN_NM + L_ * D; P.K = D; P.N = DIN; P.mode = 3; } \
        else { r_ -= I_IN; P.W = IN_WOUT + oout_; P.WT = (bf16*)(wl_ + WL_OUT); P.gain = nullptr; P.K = D; P.N = D; P.mode = 0; } \
        const int nblk_ = (P.N + 31) / 32; P.k0 = 64 * (r_ / nblk_); P.n0 = 32 * (r_ % nblk_); } while (0)
    { PItem pa, pb; float wa[32], wb[32]; int it = F.gw; bool va = it < TOTAL;
      if (va) { PRO_DECODE(it, pa); pitem_load(pa, F.lane, wa); }
      while (va) {
          const int itb = it + F.NGW; const bool vb = itb < TOTAL;
          if (vb) { PRO_DECODE(itb, pb); pitem_load(pb, F.lane, wb); }
          pitem_store(pa, F.lane, scr, wa);
          if (!vb) break;
          it = itb + F.NGW; va = it < TOTAL;
          if (va) { PRO_DECODE(it, pa); pitem_load(pa, F.lane, wa); }
          pitem_store(pb, F.lane, scr, wb);
      } }
#undef PRO_DECODE
    for (int L = 0; L < DEPTH; ++L) { v4u* p = (v4u*)(F.ws + WS_W + (size_t)L * WL_STRIDE + WL_IN + (size_t)DIN * D * 2);
        for (int i = F.gw * 64 + F.lane; i < (LDP - DIN) * D * 2 / 16; i += F.NGW * 64) p[i] = (v4u){0u, 0u, 0u, 0u}; }
    { bf16* xb = (bf16*)(F.ws + WS_XN); float* rss = (float*)(F.ws + WS_RSS);
      for (int m = F.gw; m < M; m += F.NGW) { const f32x4* xr = (const f32x4*)(IN_X + (size_t)m * D) + F.lane; v2u* o = (v2u*)(xb + (size_t)m * D) + F.lane; float s = 0.f;
#pragma unroll
          for (int j = 0; j < 8; ++j) { const f32x4 v = xr[64 * j]; s += (v.x * v.x + v.y * v.y) + (v.z * v.z + v.w * v.w); v2u w; w.x = pk2(v.x, v.y); w.y = pk2(v.z, v.w); o[64 * j] = w; }
          s = wave_sum(s);
          if (F.lane < 32) rss[(size_t)m * 32 + F.lane] = F.lane == 0 ? s : 0.f; } }
    float* cosh_ = (float*)(F.ws + WS_COSH); float* sinh_ = (float*)(F.ws + WS_SINH); float* cosi_ = (float*)(F.ws + WS_COSI); float* sini_ = (float*)(F.ws + WS_SINI);
    for (int m = F.gw; m < M; m += F.NGW) { const float p = (float)IN_POS[m];
        { const float a = p * INV_H[F.lane]; float s, c; sincos_d((double)a, s, c); cosh_[m * 64 + F.lane] = c; sinh_[m * 64 + F.lane] = s; }
        if (F.lane < 32) { const float a = p * INV_H[2 * F.lane]; float s, c; sincos_d((double)a, s, c); cosi_[m * 32 + F.lane] = c; sini_[m * 32 + F.lane] = s; } }
}

__device__ __forceinline__ void norm_phase(Frame& F, const float* x, const float* g, bf16* xn) {
    for (int m = F.gw; m < M; m += F.NGW) {
        const f32x4* xr = (const f32x4*)(x + (size_t)m * D) + F.lane; f32x4 v[8]; float s = 0.f;
#pragma unroll
        for (int j = 0; j < 8; ++j) { v[j] = xr[64 * j]; s += (v[j].x * v[j].x + v[j].y * v[j].y) + (v[j].z * v[j].z + v[j].w * v[j].w); }
        const float r = 1.0f / sqrtf(wave_sum(s) * (1.0f / D) + RMS_EPS);
        v2u* o = (v2u*)(xn + (size_t)m * D) + F.lane;
#pragma unroll
        for (int j = 0; j < 8; ++j) { const f32x4 gg = ((const f32x4*)g)[F.lane + 64 * j]; v2u w; w.x = pk2(v[j].x * r * gg.x, v[j].y * r * gg.y); w.y = pk2(v[j].z * r * gg.z, v[j].w * r * gg.w); o[64 * j] = w; }
    }
}
__device__ __forceinline__ void final_norm_phase(Frame& F, float* x, const float* g) {
    for (int m = F.gw; m < M; m += F.NGW) {
        f32x4* xr = (f32x4*)(x + (size_t)m * D) + F.lane; f32x4 v[8]; float s = 0.f;
#pragma unroll
        for (int j = 0; j < 8; ++j) { v[j] = xr[64 * j]; s += (v[j].x * v[j].x + v[j].y * v[j].y) + (v[j].z * v[j].z + v[j].w * v[j].w); }
        const float r = 1.0f / sqrtf(wave_sum(s) * (1.0f / D) + RMS_EPS);
#pragma unroll
        for (int j = 0; j < 8; ++j) { const f32x4 gg = ((const f32x4*)g)[F.lane + 64 * j]; xr[64 * j] = v[j] * r * gg; }
    }
}

__device__ __forceinline__ void unpack8(const v4u w, float (&f)[8]) { f[0] = bf_lo(w.x); f[1] = bf_hi(w.x); f[2] = bf_lo(w.y); f[3] = bf_hi(w.y); f[4] = bf_lo(w.z); f[5] = bf_hi(w.z); f[6] = bf_lo(w.w); f[7] = bf_hi(w.w); }
__device__ __forceinline__ v4u pack8(const float (&f)[8]) { v4u w; w.x = pk2(f[0], f[1]); w.y = pk2(f[2], f[3]); w.z = pk2(f[4], f[5]); w.w = pk2(f[6], f[7]); return w; }
__device__ __forceinline__ void rope8(const bf16* p1, const bf16* p2, bf16* q1, bf16* q2, const float (&c)[8], const float (&s)[8], float sc) {
    float a[8], b[8], o1[8], o2[8]; unpack8(*(const v4u*)p1, a); unpack8(*(const v4u*)p2, b);
#pragma unroll
    for (int j = 0; j < 8; ++j) { o1[j] = (a[j] * c[j] - b[j] * s[j]) * sc; o2[j] = (b[j] * c[j] + a[j] * s[j]) * sc; }
    *(v4u*)q1 = pack8(o1); *(v4u*)q2 = pack8(o2);
}
__device__ __forceinline__ void rope_conv_phase(Frame& F, bf16* proj, bf16* ymix, const float* convw  ) {
    const float* cosh_ = (const float*)(F.ws + WS_COSH); const float* sinh_ = (const float*)(F.ws + WS_SINH); const float* cosi_ = (const float*)(F.ws + WS_COSI); const float* sini_ = (const float*)(F.ws + WS_SINI);
    const int lane = F.lane; bf16* kvc = (bf16*)(F.ws + WS_KV); bf16* kic = (bf16*)(F.ws + WS_KI);
    float cw0[8], cw1[8], cw2[8];
#pragma unroll
    for (int j = 0; j < 8; ++j) { cw0[j] = convw[8 * lane + j]; cw1[j] = convw[512 + 8 * lane + j]; cw2[j] = convw[1024 + 8 * lane + j]; }
    for (int m = F.gw; m < M; m += F.NGW) {
        bf16* row = proj + (size_t)m * LDPP;
        { const int d8 = 8 * (lane & 7), hs = lane >> 3; float c[8], s[8];
          { const f32x4 c0 = *(const f32x4*)(cosh_ + m * 64 + d8), c1 = *(const f32x4*)(cosh_ + m * 64 + d8 + 4), s0 = *(const f32x4*)(sinh_ + m * 64 + d8), s1 = *(const f32x4*)(sinh_ + m * 64 + d8 + 4);
#pragma unroll
            for (int j = 0; j < 4; ++j) { c[j] = c0[j]; c[4 + j] = c1[j]; s[j] = s0[j]; s[4 + j] = s1[j]; } }
#pragma unroll
          for (int ps = 0; ps < 3; ++ps) { const int hd = ps * 8 + hs;
              if (hd < 19) { const int base = hd < 6 ? P_QB + hd * 128 : (hd == 6 ? P_KB : (hd < 13 ? P_QC + (hd - 7) * 128 : P_KC + (hd - 13) * 128));
                  bf16* dst = hd == 6 ? kvc + (size_t)m * 256 - base : row;
                  rope8(row + base + d8, row + base + 64 + d8, dst + base + d8, dst + base + 64 + d8, c, s, 1.0f); } }
          if (lane < 16) *(v4u*)(kvc + (size_t)m * 256 + 128 + 8 * lane) = *(const v4u*)(row + P_VB + 8 * lane); }
        { const int d8 = 8 * (lane & 3), hd = lane >> 2; float c[8], s[8];
          { const f32x4 c0 = *(const f32x4*)(cosi_ + m * 32 + d8), c1 = *(const f32x4*)(cosi_ + m * 32 + d8 + 4), s0 = *(const f32x4*)(sini_ + m * 32 + d8), s1 = *(const f32x4*)(sini_ + m * 32 + d8 + 4);
#pragma unroll
            for (int j = 0; j < 4; ++j) { c[j] = c0[j]; c[4 + j] = c1[j]; s[j] = s0[j]; s[4 + j] = s1[j]; } }
          rope8(row + P_QI + hd * 64 + d8, row + P_QI + hd * 64 + 32 + d8, row + P_QI + hd * 64 + d8, row + P_QI + hd * 64 + 32 + d8, c, s, 0.125f);
          if (lane < 4) rope8(row + P_KI + d8, row + P_KI + 32 + d8, kic + (size_t)m * 64 + d8, kic + (size_t)m * 64 + 32 + d8, c, s, 1.0f); }
        { const int t = m & (SEQ - 1), ch = 8 * lane; float h0[8], g0[8], h1[8], g1[8], h2[8], g2[8], gb[8], y[8];
          unpack8(*(const v4u*)(row + P_H + ch), h0); unpack8(*(const v4u*)(row + P_GC + ch), g0); unpack8(*(const v4u*)(row + P_GB + ch), gb);
          if (t >= 1) { unpack8(*(const v4u*)(row - LDPP + P_H + ch), h1); unpack8(*(const v4u*)(row - LDPP + P_GC + ch), g1); } else {
#pragma unroll
              for (int j = 0; j < 8; ++j) { h1[j] = 0.f; g1[j] = 0.f; } }
          if (t >= 2) { unpack8(*(const v4u*)(row - 2 * LDPP + P_H + ch), h2); unpack8(*(const v4u*)(row - 2 * LDPP + P_GC + ch), g2); } else {
#pragma unroll
              for (int j = 0; j < 8; ++j) { h2[j] = 0.f; g2[j] = 0.f; } }
#pragma unroll
          for (int j = 0; j < 8; ++j) y[j] = gb[j] * (cw0[j] * (g2[j] * h2[j]) + cw1[j] * (g1[j] * h1[j]) + cw2[j] * (g0[j] * h0[j]));
          *(v4u*)(ymix + (size_t)m * D + Y_A + ch) = pack8(y); }
    }
}

__device__ __forceinline__ int crow(int r, int hi) { return (r & 3) + 8 * (r >> 2) + 4 * hi; }
constexpr int VROW = 320;
constexpr int VTILE = 32 * VROW;
struct AttnSt { f32x16 o[4]; float m, l; };
__device__ __forceinline__ void attn_init(AttnSt& st) {
#pragma unroll
    for (int d = 0; d < 4; ++d)
#pragma unroll
        for (int r = 0; r < 16; ++r) st.o[d][r] = 0.f;
    st.m = -1e30f; st.l = 0.f;
}
__device__ __forceinline__ s16x4 vtr(const LAS unsigned char* p) { return __builtin_bit_cast(s16x4, __builtin_amdgcn_ds_read_tr16_b64_v4i16((LAS s16x4*)p)); }
__device__ __forceinline__ void attn_tile(AttnSt& st, const bf16x8 (&qf)[8], const bf16* kp, const bf16* vp, LAS unsigned char* vl, unsigned vmask, int lane) {
    const int r32 = lane & 31, hi = lane >> 5;
    bf16x8 kf[8], vv[4];
#pragma unroll
    for (int ks = 0; ks < 8; ++ks) kf[ks] = *(const bf16x8*)(kp + ks * 16);
#pragma unroll
    for (int i = 0; i < 4; ++i) vv[i] = *(const bf16x8*)(vp + i * 16);
    f32x16 s;
#pragma unroll
    for (int r = 0; r < 16; ++r) s[r] = 0.f;
#pragma unroll
    for (int ks = 0; ks < 8; ++ks) s = __builtin_amdgcn_mfma_f32_32x32x16_bf16(kf[ks], qf[ks], s, 0, 0, 0);
#pragma unroll
    for (int i = 0; i < 4; ++i) *(LAS bf16x8*)(vl + r32 * VROW + (hi + 2 * i) * 16) = vv[i];
    asm volatile("" ::: "memory");
#pragma unroll
    for (int i = 0; i < 4; ++i) vv[i] = *(const bf16x8*)(vp + (i + 4) * 16);
#pragma unroll
    for (int i = 0; i < 4; ++i) *(LAS bf16x8*)(vl + r32 * VROW + (hi + 2 * (i + 4)) * 16) = vv[i];
    __builtin_amdgcn_sched_barrier(0);
    float mx = -INFINITY;
#pragma unroll
    for (int r = 0; r < 16; ++r) { s[r] = ((vmask >> r) & 1u) ? s[r] : -INFINITY; mx = fmaxf(mx, s[r]); }
    mx = fmaxf(mx, __shfl_xor(mx, 32));
    const float mn = fmaxf(st.m, mx), alpha = __builtin_amdgcn_exp2f((st.m - mn) * SM_C), mc = -mn * SM_C;
    st.m = mn;
    float ps = 0.f;
#pragma unroll
    for (int r = 0; r < 16; ++r) { s[r] = __builtin_amdgcn_exp2f(fmaf(s[r], SM_C, mc)); ps += s[r]; }
    st.l = st.l * alpha + ps;
#pragma unroll
    for (int d = 0; d < 4; ++d) st.o[d] = st.o[d] * alpha;
    bf16x8 pf[2];
#pragma unroll
    for (int sx = 0; sx < 2; ++sx) { v4u w; w.x = pk2(s[8 * sx + 0], s[8 * sx + 1]); w.y = pk2(s[8 * sx + 2], s[8 * sx + 3]); w.z = pk2(s[8 * sx + 4], s[8 * sx + 5]); w.w = pk2(s[8 * sx + 6], s[8 * sx + 7]); pf[sx] = __builtin_bit_cast(bf16x8, w); }
    __builtin_amdgcn_sched_barrier(0);
    const int g4 = lane >> 4, qq = (lane >> 2) & 3, pp = lane & 3;
    const LAS unsigned char* vb = vl + (4 * (g4 >> 1) + qq) * VROW + (16 * (g4 & 1) + 4 * pp) * 2;
#pragma unroll
    for (int d = 0; d < 4; ++d)
#pragma unroll
        for (int sx = 0; sx < 2; ++sx) { const s16x4 lo = vtr(vb + (16 * sx) * VROW + 64 * d), h8 = vtr(vb + (16 * sx + 8) * VROW + 64 * d);
            const bf16x8 a = (bf16x8){lo[0], lo[1], lo[2], lo[3], h8[0], h8[1], h8[2], h8[3]};
            st.o[d] = __builtin_amdgcn_mfma_f32_32x32x16_bf16(a, pf[sx], st.o[d], 0, 0, 0); if (sx == 1) __builtin_amdgcn_sched_barrier(0); }
}

typedef float f32x2 __attribute__((ext_vector_type(2)));
__device__ __forceinline__ float relu1(float x) { const int i = __builtin_bit_cast(int, x); return __builtin_bit_cast(float, i > 0 ? i : 0); }
constexpr int KIROW = 144;
__device__ __forceinline__ void idx_decode(int u, int& b, int& tt, int& kc) { b = u / 544; int r = u % 544; int q = 0; while (r >= 4 * (q + 1)) { r -= 4 * (q + 1); ++q; } tt = 4 * q + r / (q + 1); kc = r % (q + 1); }
__device__ __forceinline__ void indexer_run(Frame& F, const bf16* proj, float* scores, int u0, int nu) {
    const int lane = F.lane, r32 = lane & 31, hi = lane >> 5;
    LAS unsigned char* kl = F.lds + NWAVES * VTILE;
    const bf16* kibase = (const bf16*)(F.ws + WS_KI);
    bf16x8 qa[4][4]; float wv[4][16]; v4u st[4];
    int pb_ = -1, ptt = -1;
    int b, tt, kc; idx_decode(u0, b, tt, kc);
    for (int iu = 0; iu < nu; ++iu) {
        const int t0 = tt * 64 + F.wave * 8;
        { const bf16* kib = kibase + (size_t)(b * SEQ + kc * 256) * 64;
#pragma unroll
          for (int i = 0; i < 4; ++i) st[i] = *(const v4u*)(kib + (size_t)((F.tid >> 3) + 64 * i) * 64 + 8 * (F.tid & 7)); }
        if (b != pb_ || tt != ptt) {
            const int tsel = (r32 >> 2) & 1, head = 4 * (r32 >> 3) + (r32 & 3);
#pragma unroll
            for (int a = 0; a < 4; ++a) { const bf16* qp = proj + (size_t)(b * SEQ + t0 + 2 * a + tsel) * LDPP + P_QI + head * 64 + hi * 8;
#pragma unroll
                for (int ks = 0; ks < 4; ++ks) qa[a][ks] = *(const bf16x8*)(qp + ks * 16);
                const v4u* wp = (const v4u*)(proj + (size_t)(b * SEQ + t0 + 2 * a + hi) * LDPP + P_WI); const v4u w0 = wp[0], w1 = wp[1];
                const unsigned ww[8] = {w0.x, w0.y, w0.z, w0.w, w1.x, w1.y, w1.z, w1.w};
#pragma unroll
                for (int j = 0; j < 8; ++j) { wv[a][2 * j] = 0.25f * bf_lo(ww[j]); wv[a][2 * j + 1] = 0.25f * bf_hi(ww[j]); } }
            pb_ = b; ptt = tt; }
        __syncthreads();
#pragma unroll
        for (int i = 0; i < 4; ++i) *(LAS v4u*)(kl + ((F.tid >> 3) + 64 * i) * KIROW + (F.tid & 7) * 16) = st[i];
        __syncthreads();
        const int cb = b, ckc = kc;
        if (iu + 1 < nu) idx_decode(u0 + iu + 1, b, tt, kc);
        for (int kt = 0; kt < 8; ++kt) {
            const int k0 = ckc * 256 + kt * 32;
            const LAS unsigned char* kp = kl + (kt * 32 + r32) * KIROW + hi * 16;
            bf16x8 kf[4];
#pragma unroll
            for (int ks = 0; ks < 4; ++ks) kf[ks] = *(const LAS bf16x8*)(kp + ks * 32);
            f32x16 acc[4];
#pragma unroll
            for (int a = 0; a < 4; ++a) {
#pragma unroll
                for (int r = 0; r < 16; ++r) acc[a][r] = 0.f;
#pragma unroll
                for (int ks = 0; ks < 4; ++ks) acc[a] = __builtin_amdgcn_mfma_f32_32x32x16_bf16(qa[a][ks], kf[ks], acc[a], 0, 0, 0); }
#pragma unroll
            for (int a = 0; a < 4; ++a) {
                f32x2 s0 = (f32x2){0.f, 0.f}, s1 = (f32x2){0.f, 0.f};
#pragma unroll
                for (int r = 0; r < 16; r += 4) {
                    f32x2 x0, x1; x0.x = relu1(acc[a][r]); x0.y = relu1(acc[a][r + 1]); x1.x = relu1(acc[a][r + 2]); x1.y = relu1(acc[a][r + 3]);
                    s0 = __builtin_elementwise_fma((f32x2){wv[a][r], wv[a][r + 1]}, x0, s0); s1 = __builtin_elementwise_fma((f32x2){wv[a][r + 2], wv[a][r + 3]}, x1, s1); }
                const float sc = (s0.x + s0.y) + (s1.x + s1.y);
                scores[(size_t)(cb * SEQ + t0 + 2 * a + hi) * SEQ + k0 + r32] = sc; }
        }
    }
}
__device__ __forceinline__ void dilated_unit(Frame& F, const bf16* proj, bf16* ymix, float* lse, int wu) {
    const int lane = F.lane, r32 = lane & 31, hi = lane >> 5;
    const int b = wu / 768; int rem = wu % 768; const int g = rem >> 8; rem &= 255; const int hh = rem >> 7, ti = rem & 127;
    const int sh = 2 * g, dl = 1 << sh, tpc = 128 >> sh;
    const int r = ti / tpc, i0 = (ti % tpc) * 32, hd = g * 2 + hh;
    LAS unsigned char* vl = F.lds + F.wave * VTILE;
    const int tq = r + dl * (i0 + r32);
    bf16x8 qf[8];
    { const bf16* qp = proj + (size_t)(b * SEQ + tq) * LDPP + P_QC + hd * 128 + hi * 8;
#pragma unroll
      for (int ks = 0; ks < 8; ++ks) qf[ks] = *(const bf16x8*)(qp + ks * 16); }
    AttnSt st; attn_init(st);
    for (int kt = 0; kt < 5; ++kt) {
        const int ib = i0 - 128 + 32 * kt;
        if (ib + 31 < 0) continue;
        const int ik = ib + r32, ikc = ik < 0 ? 0 : ik;
        const bf16* rowp = proj + (size_t)(b * SEQ + r + dl * ikc) * LDPP + hd * 128 + hi * 8;
        unsigned vmask = 0u; const int iq = i0 + r32;
#pragma unroll
        for (int rr = 0; rr < 16; ++rr) { const int ikey = ib + crow(rr, hi); vmask |= (ikey >= 0 && ikey <= iq && ikey >= iq - 128) ? (1u << rr) : 0u; }
        attn_tile(st, qf, rowp + P_KC, rowp + P_VC, vl, vmask, lane);
    }
    const float lt = st.l + __shfl_xor(st.l, 32), inv = 1.0f / lt;
    bf16* op = ymix + (size_t)(b * SEQ + tq) * D + Y_C + hd * 128;
#pragma unroll
    for (int d = 0; d < 4; ++d)
#pragma unroll
        for (int r4 = 0; r4 < 4; ++r4) { v2u w; w.x = pk2(st.o[d][4 * r4] * inv, st.o[d][4 * r4 + 1] * inv); w.y = pk2(st.o[d][4 * r4 + 2] * inv, st.o[d][4 * r4 + 3] * inv);
            *(v2u*)(op + 32 * d + 8 * r4 + 4 * hi) = w; }
    if (hi == 0) lse[(size_t)(b * SEQ + tq) * 6 + hd] = st.m * SM_C + __builtin_amdgcn_logf(lt);
}
constexpr int N_IDX_UNITS = 2 * 544, N_DIL_WU = 2 * 3 * 2 * 128, N_P6_UNITS = N_IDX_UNITS + N_DIL_WU / NWAVES;
__device__ __forceinline__ void p6_phase(Frame& F, const bf16* proj, bf16* ymix, float* scores, float* lse, const int pmode  ) {
    constexpr int NDU = N_DIL_WU / NWAVES;
    const int G = F.G, w = F.bid;
    const int nd = NDU < G ? NDU : G;
    const int total = N_IDX_UNITS + nd;
    const int per = total / G, rem = total % G;
    int slots = per + (w < rem ? 1 : 0);
    int first = 0;
    { const int wl = w < rem ? w : rem; first = w * per + wl - (w < nd ? w : nd); }
    const int nidx = slots - (w < nd ? 1 : 0);
    if (!(pmode & 2) && nidx > 0 && first < N_IDX_UNITS) indexer_run(F, proj, scores, first, first + nidx <= N_IDX_UNITS ? nidx : N_IDX_UNITS - first);
    if (!(pmode & 1)) for (int du = w; du < NDU; du += G) dilated_unit(F, proj, ymix, lse, du * NWAVES + F.wave);
}

constexpr float DSA_THR = 8.0f / SM_C;
constexpr int VROW2 = 288;
using pg8::swap16; using pg8::swap32; using pg8::xadd16; using pg8::xadd32;
__device__ __forceinline__ float xmax16(float v) { float a = v, b = v; swap16(a, b); return fmaxf(a, b); }
__device__ __forceinline__ float xmax32(float v) { float a = v, b = v; swap32(a, b); return fmaxf(a, b); }
__device__ __forceinline__ void dsa_attn(Frame& F, const bf16* proj, bf16* ymix, int m, int b, int nsel, LAS int* list, LAS unsigned char* vl, const int pmode  ) {
    const int lane = F.lane, c16 = lane & 15, g = lane >> 4, r32 = lane & 31, hi = lane >> 5;
    bf16x8 qf[4];
    { const bf16* qp = proj + (size_t)m * LDPP + P_QB + (c16 < 6 ? c16 : 0) * 128 + 8 * g;
#pragma unroll
      for (int ks = 0; ks < 4; ++ks) { qf[ks] = *(const bf16x8*)(qp + 32 * ks); if (c16 >= 6) qf[ks] = (bf16x8){0, 0, 0, 0, 0, 0, 0, 0}; } }
    f32x4 o[8];
#pragma unroll
    for (int d = 0; d < 8; ++d) o[d] = (f32x4){0.f, 0.f, 0.f, 0.f};
    float mrun = -1e30f, lrun = 0.f;
    const int ntile = (nsel + 31) >> 5;
    const bf16* kvb = (const bf16*)(F.ws + WS_KV) + (size_t)(b * SEQ) * 256;
    bf16x8 ka[8], kb8[8], vv[8];
    const LAS unsigned char* vb = vl + (4 * g + (c16 >> 2)) * VROW2 + (4 * (c16 & 3)) * 2;
#define DSA_LOADK(KDST, KT) do { const int s0_ = (KT) * 32 + c16, s1_ = s0_ + 16; k0_ = s0_ < nsel ? list[s0_] : 0; k1_ = s1_ < nsel ? list[s1_] : 0; \
        const bf16* p0_ = kvb + (size_t)k0_ * 256 + 8 * g; const bf16* p1_ = kvb + (size_t)k1_ * 256 + 8 * g; \
        _Pragma("unroll") for (int ks = 0; ks < 4; ++ks) { KDST[ks] = *(const bf16x8*)(p0_ + 32 * ks); KDST[4 + ks] = *(const bf16x8*)(p1_ + 32 * ks); } } while (0)
#define DSA_LOADV() do {   \
        _Pragma("unroll") for (int i = 0; i < 8; ++i) { const int sl_ = vkt_ * 32 + 8 * (i >> 1) + (lane >> 3); const int kk_ = sl_ < nsel ? list[sl_] : 0; \
            vv[i] = *(const bf16x8*)(kvb + (size_t)kk_ * 256 + 128 + 8 * (8 * (i & 1) + (lane & 7))); } } while (0)
#define DSA_TILE(KCUR, KNXT, KT) do { \
        const int ktn_ = (KT) + 1 < ntile ? (KT) + 1 : (KT); \
        if (!(pmode & 8)) DSA_LOADK(KNXT, ktn_); \
        __builtin_amdgcn_sched_barrier(0); \
        f32x4 sa = (f32x4){0.f, 0.f, 0.f, 0.f}, sb = (f32x4){0.f, 0.f, 0.f, 0.f}; \
        _Pragma("unroll") for (int ks = 0; ks < 4; ++ks) { sa = __builtin_amdgcn_mfma_f32_16x16x32_bf16(KCUR[ks], qf[ks], sa, 0, 0, 0); sb = __builtin_amdgcn_mfma_f32_16x16x32_bf16(KCUR[4 + ks], qf[ks], sb, 0, 0, 0); } \
        if (!(pmode & 4)) { _Pragma("unroll") for (int i = 0; i < 8; ++i) *(LAS bf16x8*)(vl + (8 * (i >> 1) + (lane >> 3)) * VROW2 + (8 * (i & 1) + (lane & 7)) * 16) = vv[i]; \
        vkt_ = ktn_; DSA_LOADV(); } \
        __builtin_amdgcn_sched_barrier(0); \
        const int kb_ = (KT) * 32 + 4 * g; float mx = -INFINITY; \
        _Pragma("unroll") for (int j = 0; j < 4; ++j) { sa[j] = (kb_ + j < nsel) ? sa[j] : -INFINITY; sb[j] = (kb_ + 16 + j < nsel) ? sb[j] : -INFINITY; mx = fmaxf(mx, fmaxf(sa[j], sb[j])); } \
        if (__builtin_amdgcn_ballot_w64(mx > mrun + DSA_THR) != 0ull) {     \
            mx = xmax16(mx); mx = xmax32(mx); \
            const float mn = fmaxf(mrun, mx), alpha = __builtin_amdgcn_exp2f((mrun - mn) * SM_C); mrun = mn; lrun *= alpha; \
            _Pragma("unroll") for (int d = 0; d < 8; ++d) o[d] = o[d] * alpha; } \
        const float mc = -mrun * SM_C; float ps = 0.f; \
        _Pragma("unroll") for (int j = 0; j < 4; ++j) { sa[j] = __builtin_amdgcn_exp2f(fmaf(sa[j], SM_C, mc)); sb[j] = __builtin_amdgcn_exp2f(fmaf(sb[j], SM_C, mc)); ps += sa[j] + sb[j]; } \
        lrun += ps; \
        v4u pw; pw.x = pg8::cvt_pk_bf16(sa[0], sa[1]); pw.y = pg8::cvt_pk_bf16(sa[2], sa[3]); pw.z = pg8::cvt_pk_bf16(sb[0], sb[1]); pw.w = pg8::cvt_pk_bf16(sb[2], sb[3]); \
        const bf16x8 pf = __builtin_bit_cast(bf16x8, pw); \
        if (!(pmode & 4)) { _Pragma("unroll") for (int d = 0; d < 8; ++d) { const s16x4 lo = vtr(vb + 32 * d), h8 = vtr(vb + 16 * VROW2 + 32 * d); \
            const bf16x8 a = __builtin_shufflevector(lo, h8, 0, 1, 2, 3, 4, 5, 6, 7); \
            o[d] = __builtin_amdgcn_mfma_f32_16x16x32_bf16(a, pf, o[d], 0, 0, 0); } } else { o[0][0] += sa[0]; } \
        __builtin_amdgcn_sched_barrier(0); } while (0)
    int k0_, k1_, vkt_ = 0;
    DSA_LOADK(ka, 0); DSA_LOADV();
    for (int kt = 0; kt < ntile; kt += 2) {
        DSA_TILE(ka, kb8, kt);
        if (kt + 1 < ntile) DSA_TILE(kb8, ka, kt + 1);
    }
#undef DSA_TILE
#undef DSA_LOADV
#undef DSA_LOADK
    const float lt = xadd32(xadd16(lrun)), inv = 1.0f / lt;
    if (c16 < 6) { bf16* op = ymix + (size_t)m * D + Y_B + c16 * 128 + 4 * g;
#pragma unroll
        for (int d = 0; d < 8; ++d) { v2u w; w.x = pk2(o[d][0] * inv, o[d][1] * inv); w.y = pk2(o[d][2] * inv, o[d][3] * inv); *(v2u*)(op + 16 * d) = w; } }
}

__device__ __forceinline__ unsigned f2ord(float f) { const unsigned b = __builtin_bit_cast(unsigned, f); return b ^ ((unsigned)((int)b >> 31) | 0x80000000u); }
typedef unsigned short u16x2 __attribute__((ext_vector_type(2)));
__device__ __forceinline__ int wave_sum_i(int v) {
    v += __builtin_amdgcn_update_dpp(0, v, 0xB1, 0xF, 0xF, false);
    v += __builtin_amdgcn_update_dpp(0, v, 0x4E, 0xF, 0xF, false);
    v += __builtin_amdgcn_update_dpp(0, v, 0x141, 0xF, 0xF, false);
    v += __builtin_amdgcn_update_dpp(0, v, 0x140, 0xF, 0xF, false);
    return __builtin_amdgcn_readlane(v, 0) + __builtin_amdgcn_readlane(v, 16) + __builtin_amdgcn_readlane(v, 32) + __builtin_amdgcn_readlane(v, 48);
}
__device__ __forceinline__ unsigned pk_count_gt(unsigned acc, unsigned h, unsigned C, unsigned one2) {
    unsigned d; asm("v_pk_sub_u16 %0, %1, %2 clamp\n\tv_pk_min_u16 %0, %0, %3\n\tv_pk_add_u16 %0, %0, %4" : "=&v"(d) : "v"(h), "v"(C), "v"(one2), "v"(acc)); return d; }
__device__ __forceinline__ int lane_prefix(unsigned long long mask) { return __builtin_amdgcn_mbcnt_hi((unsigned)(mask >> 32), __builtin_amdgcn_mbcnt_lo((unsigned)mask, 0u)); }
__device__ __forceinline__ void p7_phase(Frame& F, const bf16* proj, bf16* ymix, const float* scores, const float* lse, const int pmode  ) {
    const int lane = F.lane;
    LAS unsigned char* vl = F.lds + F.wave * VTILE;
    LAS int* list = (LAS int*)(F.lds + NWAVES * VTILE + F.wave * 2048);
    LAS unsigned* cand = (LAS unsigned*)(F.lds + NWAVES * VTILE + F.wave * 2048 + 1024);
    const int per_b = F.NGW >> 1;
    unsigned guess = 0u;
    for (int it = (F.bid >> 1) * NWAVES + F.wave; it < SEQ; it += per_b) {
        const int b = F.bid & 1, t = it, m = b * SEQ + t;
        int ln = lane; asm volatile("" : "+v"(ln));
        { float ls[6];
#pragma unroll
          for (int i = 0; i < 6; ++i) ls[i] = lse[(size_t)m * 6 + i];
          unsigned* yc = (unsigned*)(ymix + (size_t)m * D + Y_C);
#pragma unroll
          for (int hh = 0; hh < 2; ++hh) { const float mx = fmaxf(ls[hh], fmaxf(ls[2 + hh], ls[4 + hh]));
              const float e0 = __builtin_amdgcn_exp2f(ls[hh] - mx), e1 = __builtin_amdgcn_exp2f(ls[2 + hh] - mx), e2 = __builtin_amdgcn_exp2f(ls[4 + hh] - mx), rs = 1.0f / (e0 + e1 + e2);
              const float al[3] = {e0 * rs, e1 * rs, e2 * rs};
#pragma unroll
              for (int g = 0; g < 3; ++g) { const int idx = (g * 2 + hh) * 64 + lane; const unsigned w = yc[idx]; yc[idx] = pk2(bf_lo(w) * al[g], bf_hi(w) * al[g]); } } }
        unsigned u[64];
        { const float* sp = scores + (size_t)m * SEQ + ln; float f[64];
#pragma unroll
          for (int j = 0; j < 32; ++j) f[j] = __builtin_nontemporal_load(sp + j * 64);
          if (t >= 2048) {
#pragma unroll
              for (int j = 32; j < 64; ++j) f[j] = __builtin_nontemporal_load(sp + j * 64);
          } else {
#pragma unroll
              for (int j = 32; j < 64; ++j) f[j] = 0.f;
          }
#pragma unroll
          for (int j = 0; j < 64; ++j) u[j] = (ln <= t - j * 64) ? f2ord(f[j]) : 0u; }
        unsigned B = 0u; int need = 0;
        if (t + 1 > 256 && !(pmode & 2)) {
            unsigned h[32];
#pragma unroll
            for (int jj = 0; jj < 32; ++jj) h[jj] = (u[2 * jj] >> 16) | (u[2 * jj + 1] & 0xffff0000u);
            unsigned lo = 0u, hi = 0x10000u; int chi = 0;
#define P7_COUNT_GE(CNT, CVAL) do { const unsigned cm1_ = (CVAL) - 1u, C_ = cm1_ | (cm1_ << 16); unsigned acc_ = 0u; \
                _Pragma("unroll") for (int jj = 0; jj < 32; ++jj) acc_ = pk_count_gt(acc_, h[jj], C_, 0x00010001u); \
                CNT = wave_sum_i((int)((acc_ & 0xffffu) + (acc_ >> 16))); } while (0)
            if (guess > 256u) { const unsigned p = guess - 128u; int cnt; P7_COUNT_GE(cnt, p); if (cnt >= 256) lo = p; else { hi = p; chi = cnt; }
                if (lo == p) { const unsigned q = guess + 128u < 0xffffu ? guess + 128u : 0xffffu; P7_COUNT_GE(cnt, q); if (cnt >= 256) lo = q; else { hi = q; chi = cnt; } } }
            while (hi - lo > 1u) { const unsigned mid = (lo + hi) >> 1; int cnt; P7_COUNT_GE(cnt, mid); if (cnt >= 256) lo = mid; else { hi = mid; chi = cnt; } }
#undef P7_COUNT_GE
            B = lo; guess = B; need = 256 - chi;
        }
        int nsel = 0, ncand = 0;
#pragma unroll
        for (int j = 0; j < 64; ++j) {
            const unsigned hv = u[j] >> 16;
            const bool gt = hv > B;
            const unsigned long long mg = __ballot(gt);
            if (gt) list[nsel + lane_prefix(mg)] = j * 64 + ln;
            nsel += __popcll(mg);
            if (B != 0u) { const bool eq = hv == B; const unsigned long long me = __ballot(eq);
                if (me != 0ull) { const int p = ncand + lane_prefix(me); if (eq && p < 64) { cand[2 * p] = u[j]; cand[2 * p + 1] = (unsigned)(j * 64 + ln); } ncand += __popcll(me); } }
            if ((j & 3) == 3) __builtin_amdgcn_sched_barrier(0);
        }
        if (need > 0) {
            const int nc = ncand < 64 ? ncand : 64;
            const unsigned cv = lane < nc ? cand[2 * lane] : 0u, ck = lane < nc ? cand[2 * lane + 1] : 0xffffffffu;
            int rank = 0;
            for (int j = 0; j < nc; ++j) { const unsigned sv = __builtin_amdgcn_readlane(cv, j), sk = __builtin_amdgcn_readlane(ck, j); rank += (sv > cv || (sv == cv && sk < ck)) ? 1 : 0; }
            const bool take = lane < nc && rank < need;
            const unsigned long long mt = __ballot(take);
            if (take) list[nsel + lane_prefix(mt)] = (int)ck;
            nsel += __popcll(mt);
        }
        if (pmode & 2) nsel = nsel > 256 ? 256 : nsel;
        if (!(pmode & 1)) dsa_attn(F, proj, ymix, m, b, nsel, list, vl, pmode);
    }
}

constexpr int PH_PRO = 0, PH_PER_LAYER = 9, PH_FINAL = 1 + DEPTH * PH_PER_LAYER, N_PHASES = PH_FINAL + 1;
__global__ void __launch_bounds__(NWAVES * 64, 2) fwd_kernel(Args args) {
    extern __shared__ __attribute__((aligned(16))) unsigned char lds[];
    Frame F;
    F.lds = (LAS unsigned char*)lds; F.tid = threadIdx.x; F.lane = F.tid & 63; F.wave = __builtin_amdgcn_readfirstlane(F.tid >> 6); F.bid = blockIdx.x;
    const int wave0 = F.wave;
    F.G = gridDim.x; F.gw = blockIdx.x * NWAVES + F.wave; F.NGW = F.G * NWAVES; F.ws = args.ws;
    volatile LAS unsigned* MISC = (volatile LAS unsigned*)(F.lds + MISC_OFF);
    for (int i = F.tid; i < (LDS_BYTES - RING_BYTES) / 4; i += NWAVES * 64) ((LAS unsigned*)(F.lds + RING_BYTES))[i] = 0u;
    __syncthreads();
    const int lo = args.ph_lo, hi = args.ph_hi;
    XcdBarrier bar; bar.bar = (unsigned*)(args.ws + WS_CTL) + CW_BAR; bar.x = 0; bar.st = nullptr;
    if (hi - lo > 1) bar = xcd_barrier_post((unsigned*)(args.ws + WS_CTL) + CW_BAR, MISC + 8);
#define IN(k) (lo <= (k) && (k) < hi)
#ifndef PHMASK
#define PHMASK 0xFFFF
#endif
#define PHM(b) ((PHMASK >> (b)) & 1)
#define RELANE() do { int w_ = wave0, b_ = blockIdx.x; asm volatile("" : "+s"(w_), "+s"(b_)); int l_; asm volatile("v_mbcnt_lo_u32_b32 %0, -1, 0\n\tv_mbcnt_hi_u32_b32 %0, -1, %0" : "=v"(l_)); F.wave = w_; F.bid = b_; F.lane = l_; F.tid = w_ * 64 + l_; F.gw = b_ * NWAVES + w_; } while (0)
#define SEAM(k) do { if (IN(k) && IN((k) + 1)) xcd_barrier(bar); } while (0)
    float* X = args.out;
    bf16* XB = (bf16*)(args.ws + WS_XN); float* RSS = (float*)(args.ws + WS_RSS); bf16* YMIX = (bf16*)(args.ws + WS_YMIX); bf16* HB = (bf16*)(args.ws + WS_H); bf16* PROJ = (bf16*)(args.ws + WS_PROJ);
    float* SCORES = (float*)(args.ws + WS_SCORES); float* LSE = (float*)(args.ws + WS_LSE);

#ifndef PROBEMASK
#define PROBEMASK 0
#endif
#ifndef PROBE_NX
#define PROBE_NX 4
#endif
#define XPM(b) ((PROBEMASK >> (b)) & 1)
#ifndef PROBE_NOR
#define PROBE_NOR 0
#endif
#ifndef PROBE_P6MODE
#define PROBE_P6MODE 0
#endif
#ifndef PROBE_P7MODE
#define PROBE_P7MODE 0
#endif
#define PHASE(k, b, ...) do { if (PHM(b) && (extra ? XPM(b) : IN(k))) { RELANE(); __VA_ARGS__ } if (extra ? XPM(b) : (IN(k) && IN((k) + 1))) xcd_barrier(bar); } while (0)
    { for (int r_ = 0; r_ < 1 + XPM(0) * PROBE_NX; ++r_) { if (r_) xcd_barrier(bar); if (PHM(0) && IN(PH_PRO)) { RELANE(); prologue(F, args); } } SEAM(PH_PRO); }

    for (int Lx = 0; Lx < DEPTH + (PROBEMASK ? PROBE_NX : 0); ++Lx) {
        const bool extra = Lx >= DEPTH; const int L = extra ? DEPTH - 1 : Lx;
        const int pb = 1 + L * PH_PER_LAYER;
        if (!extra && (hi <= pb || lo >= pb + PH_PER_LAYER)) continue;
        if (extra && !IN(PH_FINAL)) continue;
        const float rs = extra ? 0.f : 1.f;
        unsigned char* wl = args.ws + WS_W + (size_t)L * WL_STRIDE;
        PHASE(pb + 0, 2, pg8::Gemm g{XB, (const bf16*)(wl + WL_GU1), M, 2 * FF, D}; pg8::StaticOrder S; S.init(M, 2 * FF, F.G, F.bid); pg8::EpiSwiglu E{HB, FF, (extra && PROBE_NOR) ? nullptr : RSS, D};
            pg8::gemm_phase<pg8::EpiSwiglu, pg8::StaticOrder, true, true>(F.lds, g, S, E, F.tid););
        PHASE(pb + 1, 3, pg8::Gemm g{HB, (const bf16*)(wl + WL_D1), M, D, FF}; pg8::StaticOrder S; S.init(M, D, F.G, F.bid); pg8::EpiResid E{L == 0 ? IN_X : X, X, XB, RSS, D, 0.5f * rs};
            pg8::gemm_phase<pg8::EpiResid, pg8::StaticOrder, true, true>(F.lds, g, S, E, F.tid););
        PHASE(pb + 2, 4, pg8::Gemm g{XB, (const bf16*)(wl + WL_IN), M, LDP, D}; pg8::StaticOrder S; S.init(M, LDP, F.G, F.bid); pg8::EpiStoreBf16 E{PROJ, LDPP, RSS, D};
            pg8::gemm_phase<pg8::EpiStoreBf16, pg8::StaticOrder, true, true>(F.lds, g, S, E, F.tid););
        PHASE(pb + 3, 5, rope_conv_phase(F, PROJ, YMIX, IN_CW + L * 3 * 512););
        PHASE(pb + 4, 6, p6_phase(F, PROJ, YMIX, SCORES, LSE, extra ? PROBE_P6MODE : 0););
        PHASE(pb + 5, 7, p7_phase(F, PROJ, YMIX, SCORES, LSE, extra ? PROBE_P7MODE : 0););
        PHASE(pb + 6, 8, pg8::Gemm g{YMIX, (const bf16*)(wl + WL_OUT), M, D, D}; pg8::StaticOrder S; S.init(M, D, F.G, F.bid); pg8::EpiResid E{X, X, XB, RSS, D, rs};
            pg8::gemm_phase<pg8::EpiResid, pg8::StaticOrder, true, true>(F.lds, g, S, E, F.tid););
        PHASE(pb + 7, 2, pg8::Gemm g{XB, (const bf16*)(wl + WL_GU2), M, 2 * FF, D}; pg8::StaticOrder S; S.init(M, 2 * FF, F.G, F.bid); pg8::EpiSwiglu E{HB, FF, (extra && PROBE_NOR) ? nullptr : RSS, D};
            pg8::gemm_phase<pg8::EpiSwiglu, pg8::StaticOrder, true, true>(F.lds, g, S, E, F.tid););
        PHASE(pb + 8, 3, pg8::Gemm g{HB, (const bf16*)(wl + WL_D2), M, D, FF}; pg8::StaticOrder S; S.init(M, D, F.G, F.bid); pg8::EpiResid E{X, X, XB, RSS, D, 0.5f * rs};
            pg8::gemm_phase<pg8::EpiResid, pg8::StaticOrder, true, true>(F.lds, g, S, E, F.tid););
    }
    if (PHM(9) && IN(PH_FINAL)) { RELANE(); final_norm_phase(F, X, IN_NF); }
#undef IN
#undef SEAM
}

#ifndef MK_PER_PHASE
#define MK_PER_PHASE 0
#endif
extern "C" void kernel_launch(void* const* d_in, const int* in_sizes, int n_in, void* d_out, int out_size, void* d_ws, size_t ws_size, hipStream_t stream) {
    static int grid = 0;
    if (grid == 0) {
        if (n_in != 15 || out_size != M * D || ws_size < WS_END) { fprintf(stderr, "kernel_launch: unexpected shapes (n_in %d, out %d, ws %zu < %zu); nothing launched\n", n_in, out_size, ws_size, (size_t)WS_END); grid = -1; return; }
        int dev = 0, cus = 0, per_cu = 0;
        if (hipGetDevice(&dev) != hipSuccess || hipDeviceGetAttribute(&cus, hipDeviceAttributeMultiprocessorCount, dev) != hipSuccess) { grid = -1; return; }
        if (hipFuncSetAttribute((const void*)fwd_kernel, hipFuncAttributeMaxDynamicSharedMemorySize, LDS_BYTES) != hipSuccess) { fprintf(stderr, "kernel_launch: hipFuncSetAttribute failed\n"); grid = -1; return; }
        if (hipOccupancyMaxActiveBlocksPerMultiprocessor(&per_cu, (const void*)fwd_kernel, NWAVES * 64, LDS_BYTES) != hipSuccess || per_cu < 1) fprintf(stderr, "kernel_launch: occupancy query says %d\n", per_cu);
        (void)hipGetLastError();
        grid = cus;
    }
    if (grid < 0) return;
    if (hipMemsetAsync((char*)d_ws + WS_CTL, 0, CTL_ZERO_BYTES, stream) != hipSuccess) return;
    Args a{};
    for (int i = 0; i < 15; ++i) a.in[i] = d_in[i];
    a.out = (float*)d_out; a.ws = (unsigned char*)d_ws;
#if MK_PER_PHASE
    for (int p = 0; p < N_PHASES; ++p) { a.ph_lo = p; a.ph_hi = p + 1; hipLaunchKernelGGL(fwd_kernel, dim3(grid), dim3(NWAVES * 64), LDS_BYTES, stream, a); }
#else
    a.ph_lo = 0; a.ph_hi = N_PHASES;
    hipLaunchKernelGGL(fwd_kernel, dim3(grid), dim3(NWAVES * 64), LDS_BYTES, stream, a);
#endif
}
```
